# Optimizing an MI355X kernel written in HIP

```python
import math
import jax, jax.numpy as jnp
from jax import lax
import numpy as np


D_MODEL = 1024
BATCH = 4
SEQ = 8192
DEPTH = 1

CHUNK = 64
EPS = 1e-6
A_HEADS = 8
A_DK = 128
A_DV = 256
CONV_W = 4
B_HEADS = 4
B_DK = 256
B_DV = 512
ROPE_BASE = 10000.0
D_FF = 4 * D_MODEL

A_QK = A_HEADS * A_DK
A_V = A_HEADS * A_DV
B_QK = B_HEADS * B_DK
B_V = B_HEADS * B_DV
IN_SIZES = (A_QK, A_QK, A_V, A_V, A_HEADS, A_HEADS, B_QK, B_QK, B_V, B_V, D_MODEL, D_MODEL)
D_IN = sum(IN_SIZES)

kernel_name = "hybrid_gdn_retention_sandwich_block"


def rmsnorm(x, w):
    xf = x.astype(jnp.float32)
    y = xf * lax.rsqrt(jnp.mean(xf * xf, axis=-1, keepdims=True) + EPS)
    return (y * w.astype(jnp.float32)).astype(x.dtype)


def l2norm(x):
    xf = x.astype(jnp.float32)
    return (xf * lax.rsqrt(jnp.sum(xf * xf, axis=-1, keepdims=True) + EPS)).astype(x.dtype)


def _split_cols(t, sizes):
    out, start = [], 0
    for s in sizes:
        out.append(t[..., start:start + s])
        start += s
    return out


def causal_depthwise_conv(x, w):
    k_taps, s = w.shape[0], x.shape[1]
    xp = jnp.pad(x, ((0, 0), (k_taps - 1, 0), (0, 0)))
    y = xp[:, 0:s] * w[0]
    for j in range(1, k_taps):
        y = y + xp[:, j:j + s] * w[j]
    return y


def rotary(t, positions):
    d = t.shape[-1]
    inv_freq = ROPE_BASE ** (-jnp.arange(0, d, 2, dtype=jnp.float32) / d)
    ang = positions.astype(jnp.float32)[:, None] * inv_freq[None, :]
    cos = jnp.cos(ang)[None, :, None, :]
    sin = jnp.sin(ang)[None, :, None, :]
    t1, t2 = t[..., :d // 2], t[..., d // 2:]
    return jnp.concatenate([t1 * cos - t2 * sin, t1 * sin + t2 * cos], axis=-1).astype(t.dtype)


def to_chunks(t):
    b, s, h = t.shape[:3]
    t = t.reshape(b, s // CHUNK, CHUNK, h, *t.shape[3:])
    return jnp.moveaxis(t, 3, 1)


def from_chunks(t):
    t = jnp.moveaxis(t, 1, 3)
    return t.reshape(t.shape[0], t.shape[1] * t.shape[2], *t.shape[3:])


def chunk_gated_delta_rule(q, k, v, beta, g):
    dtype = v.dtype
    q, k, v = (to_chunks(t.astype(jnp.float32)) for t in (q, k, v))
    beta, g = (to_chunks(t.astype(jnp.float32)) for t in (beta, g))
    g_cum = jnp.cumsum(g, axis=-1)
    idx = jnp.arange(CHUNK)
    causal = idx[:, None] >= idx[None, :]
    strict = idx[:, None] > idx[None, :]
    decay = jnp.exp(jnp.where(causal, g_cum[..., :, None] - g_cum[..., None, :], -jnp.inf))
    k_beta = k * beta[..., None]
    lower = jnp.where(strict, jnp.einsum('bhncd,bhnmd->bhncm', k_beta, k) * decay, 0.0)
    eye = jnp.broadcast_to(jnp.eye(CHUNK, dtype=jnp.float32), lower.shape)
    t_inv = lax.linalg.triangular_solve(lower, eye, left_side=True, lower=True, unit_diagonal=True)
    u = jnp.einsum('bhncm,bhnme->bhnce', t_inv, v * beta[..., None])
    w = jnp.einsum('bhncm,bhnmd->bhncd', t_inv, k_beta * jnp.exp(g_cum)[..., None])
    attn = jnp.where(causal, jnp.einsum('bhncd,bhnmd->bhncm', q, k) * decay, 0.0)
    q_exp = q * jnp.exp(g_cum)[..., None]
    g_last = g_cum[..., -1:]
    k_dec = k * jnp.exp(g_last - g_cum)[..., None]
    last_dec = jnp.exp(g_last[..., 0])

    def step(state, inp):
        qe, ww, uu, aqk, kd, ld = inp
        v_new = uu - jnp.einsum('bhck,bhkv->bhcv', ww, state)
        o = jnp.einsum('bhck,bhkv->bhcv', qe, state) + jnp.einsum('bhcm,bhmv->bhcv', aqk, v_new)
        state = state * ld[..., None, None] + jnp.einsum('bhck,bhcv->bhkv', kd, v_new)
        return state, o

    b, h = q.shape[0], q.shape[1]
    state0 = jnp.zeros((b, h, q.shape[-1], v.shape[-1]), jnp.float32)
    xs = tuple(jnp.moveaxis(t, 2, 0) for t in (q_exp, w, u, attn, k_dec, last_dec))
    _, o = lax.scan(step, state0, xs)
    return from_chunks(jnp.moveaxis(o, 0, 2)).astype(dtype)


def chunk_retention(q, k, v):
    dtype = v.dtype
    q, k, v = (to_chunks(t.astype(jnp.float32)) for t in (q, k, v))
    h = q.shape[1]
    log_gamma = jnp.log1p(-jnp.exp2(-5.0 - jnp.arange(h, dtype=jnp.float32)))
    pos = jnp.arange(CHUNK, dtype=jnp.float32)
    dist = jnp.abs(pos[:, None] - pos[None, :])
    intra = jnp.exp(log_gamma[:, None, None] * dist)
    scores = jnp.einsum('bhncd,bhnmd->bhncm', q, k) * intra[None, :, None]
    o_intra = jnp.einsum('bhncm,bhnme->bhnce', scores, v)
    q_dec = jnp.exp(log_gamma[:, None] * (pos + 1.0))[None, :, :, None]
    k_dec = jnp.exp(log_gamma[:, None] * (CHUNK - 1.0 - pos))[None, :, :, None]
    chunk_dec = jnp.exp(log_gamma * CHUNK)[None, :, None, None]

    def step(state, inp):
        qc, kc, vc = inp
        o = jnp.einsum('bhcd,bhde->bhce', qc * q_dec, state)
        state = state * chunk_dec + jnp.einsum('bhcd,bhce->bhde', kc * k_dec, vc)
        return state, o

    state0 = jnp.zeros((q.shape[0], h, q.shape[-1], v.shape[-1]), jnp.float32)
    xs = tuple(jnp.moveaxis(t, 2, 0) for t in (q, k, v))
    _, o_inter = lax.scan(step, state0, xs)
    o = o_intra + jnp.moveaxis(o_inter, 0, 2)
    return from_chunks(o).astype(dtype)


def hybrid_layer(x, n_mix_pre, n_mix_post, n_mlp_pre, n_mlp_post, w_in, conv_a, a_log, dt_bias,
                 norm_a, norm_b, w_br_a, w_br_b, w_out, w_up, w_down):
    b, s, _ = x.shape
    xn = rmsnorm(x, n_mix_pre)
    proj = xn @ w_in
    qa, ka, va, za, beta_logit, a_dt, qb, kb, vb, gb, gate_a, gate_b = _split_cols(proj, IN_SIZES)

    qkv = jax.nn.silu(causal_depthwise_conv(jnp.concatenate([qa, ka, va], axis=-1), conv_a))
    qa, ka, va = _split_cols(qkv, (A_QK, A_QK, A_V))
    qa = l2norm(qa.reshape(b, s, A_HEADS, A_DK)) * (A_DK ** -0.5)
    ka = l2norm(ka.reshape(b, s, A_HEADS, A_DK))
    va = va.reshape(b, s, A_HEADS, A_DV)
    beta = jax.nn.sigmoid(beta_logit)
    g = -jnp.exp(a_log) * jax.nn.softplus(a_dt + dt_bias)
    oa = chunk_gated_delta_rule(qa, ka, va, beta, g)
    oa = rmsnorm(oa, norm_a) * jax.nn.silu(za.reshape(b, s, A_HEADS, A_DV))
    ya = oa.reshape(b, s, A_V) @ w_br_a

    positions = jnp.arange(s)
    qb = rotary(qb.reshape(b, s, B_HEADS, B_DK), positions)
    kb = rotary(kb.reshape(b, s, B_HEADS, B_DK), positions) * (B_DK ** -0.5)
    vb = vb.reshape(b, s, B_HEADS, B_DV)
    ob = chunk_retention(qb, kb, vb)
    ob = rmsnorm(ob, norm_b.reshape(B_HEADS, B_DV)) * jax.nn.silu(gb.reshape(b, s, B_HEADS, B_DV))
    yb = ob.reshape(b, s, B_V) @ w_br_b

    mix = (jax.nn.sigmoid(gate_a) * ya + jax.nn.sigmoid(gate_b) * yb) @ w_out
    x = x + rmsnorm(mix, n_mix_post)

    hn = rmsnorm(x, n_mlp_pre)
    ff = jnp.square(jax.nn.relu(hn @ w_up)) @ w_down
    return x + rmsnorm(ff, n_mlp_post)


def setup_inputs(seed: int = 0) -> dict:
    key = jax.random.key(seed)
    ks = jax.random.split(key, 16)
    L = DEPTH

    def nrm(k, shape, fan_in):
        return jax.random.normal(k, shape, jnp.float32) * fan_in ** -0.5

    def gain(k, shape):
        return 1.0 + 0.05 * jax.random.normal(k, shape, jnp.float32)

    x = jax.random.normal(ks[0], (BATCH, SEQ, D_MODEL), jnp.float32)
    dt = jnp.exp(jax.random.uniform(ks[8], (L, A_HEADS), jnp.float32,
                                    minval=math.log(1e-3), maxval=math.log(1e-1)))
    dt_bias = dt + jnp.log(-jnp.expm1(-dt))
    a_log = jnp.log(jax.random.uniform(ks[9], (L, A_HEADS), jnp.float32, minval=1.0, maxval=16.0))
    return {
        "x": x,
        "norm_mix_pre": gain(ks[1], (L, D_MODEL)),
        "norm_mix_post": gain(ks[2], (L, D_MODEL)),
        "norm_mlp_pre": gain(ks[3], (L, D_MODEL)),
        "norm_mlp_post": gain(ks[4], (L, D_MODEL)),
        "w_in": nrm(ks[5], (L, D_MODEL, D_IN), D_MODEL),
        "conv_a": nrm(ks[6], (L, CONV_W, 2 * A_QK + A_V), CONV_W),
        "a_log": a_log,
        "dt_bias": dt_bias,
        "norm_a": gain(ks[7], (L, A_DV)),
        "norm_b": gain(ks[10], (L, B_V)),
        "w_br_a": nrm(ks[11], (L, A_V, D_MODEL), A_V),
        "w_br_b": nrm(ks[12], (L, B_V, D_MODEL), B_V),
        "w_out": nrm(ks[13], (L, D_MODEL, D_MODEL), D_MODEL),
        "w_up": nrm(ks[14], (L, D_MODEL, D_FF), D_MODEL),
        "w_down": nrm(ks[15], (L, D_FF, D_MODEL), D_FF),
    }


def reference(x, norm_mix_pre, norm_mix_post, norm_mlp_pre, norm_mlp_post, w_in, conv_a, a_log,
              dt_bias, norm_a, norm_b, w_br_a, w_br_b, w_out, w_up, w_down):
    for l in range(DEPTH):
        x = hybrid_layer(x, norm_mix_pre[l], norm_mix_post[l], norm_mlp_pre[l], norm_mlp_post[l],
                         w_in[l], conv_a[l], a_log[l], dt_bias[l], norm_a[l], norm_b[l],
                         w_br_a[l], w_br_b[l], w_out[l], w_up[l], w_down[l])
    return x
```

```cpp
#include <hip/hip_runtime.h>
#include <hip/hip_cooperative_groups.h>
#include <cstdio>
#include <cstdint>
namespace cg = cooperative_groups;

#define LAS __attribute__((address_space(3)))
typedef unsigned short bf16_t;
typedef short bf16x8 __attribute__((ext_vector_type(8)));
typedef float f32x4 __attribute__((ext_vector_type(4)));
typedef unsigned u32x4 __attribute__((ext_vector_type(4)));
typedef unsigned u32x2 __attribute__((ext_vector_type(2)));

constexpr int D = 1024, SEQ = 8192, NB = 4, M = NB * SEQ, MH = M / 2, DIN = 14352, FF = 4096;
constexpr int NTHREADS = 512, NWAVES = 8;
constexpr float EPS = 1e-6f;
constexpr int LDS_BYTES = 147456;
constexpr int LDO = 8192 + 64;

constexpr size_t MiB = 1u << 20;
constexpr size_t WS_W1A = 1 * MiB, WS_W1B = 17 * MiB, WS_WBRA = 29 * MiB, WS_WBRB = 33 * MiB, WS_WOUT = 37 * MiB, WS_WUP = 39 * MiB, WS_WDN = 47 * MiB;
constexpr size_t WS_ROPEC = 55 * MiB, WS_ROPES = 59 * MiB, WS_BETA = 63 * MiB, WS_GG = 64 * MiB, WS_XN = 65 * MiB, WS_OUT1 = 129 * MiB, WS_QKN = 387 * MiB;
constexpr size_t WS_TA = 451 * MiB, WS_GC = 483 * MiB, WS_SC = 484 * MiB, WS_SSQA = 492 * MiB, WS_SSQB = 500 * MiB, WS_END = 508 * MiB;

struct Params {
    const float* x; const float* n_mix_pre; const float* n_mix_post; const float* n_mlp_pre; const float* n_mlp_post;
    const float* w_in; const float* conv_a; const float* a_log; const float* dt_bias; const float* norm_a; const float* norm_b;
    const float* w_br_a; const float* w_br_b; const float* w_out; const float* w_up; const float* w_down;
    float* out; unsigned char* ws;
};

typedef float f32x2_t __attribute__((ext_vector_type(2))); typedef __bf16 bf16x2_t __attribute__((ext_vector_type(2)));
__device__ __forceinline__ unsigned pk2(float lo, float hi) { f32x2_t v = {lo, hi}; bf16x2_t b = __builtin_convertvector(v, bf16x2_t); return __builtin_bit_cast(unsigned, b); }
__device__ __forceinline__ unsigned f2bf(float f) { return pk2(f, 0.f) & 0xffffu; }
__device__ __forceinline__ float bf2f(unsigned h) { return __builtin_bit_cast(float, h << 16); }
__device__ __forceinline__ float bflo(unsigned w) { return __builtin_bit_cast(float, w << 16); }
__device__ __forceinline__ float bfhi(unsigned w) { return __builtin_bit_cast(float, w & 0xffff0000u); }
__device__ __forceinline__ float wave_sum(float v) {
#pragma unroll
    for (int o = 1; o < 64; o <<= 1) v += __shfl_xor(v, o);
    return v;
}
__device__ __forceinline__ float sigmoidf_(float z) { return __builtin_amdgcn_rcpf(1.f + __expf(-z)); }
__device__ __forceinline__ float siluf_(float z) { return z * __builtin_amdgcn_rcpf(1.f + __expf(-z)); }
template <int CTRL> __device__ __forceinline__ float dpp_f(float v) { return __builtin_bit_cast(float, __builtin_amdgcn_update_dpp(0, __builtin_bit_cast(int, v), CTRL, 0xf, 0xf, false)); }
__device__ __forceinline__ float row16_sum(float v) { v += dpp_f<0x128>(v); v += dpp_f<0x124>(v); v += dpp_f<0x122>(v); v += dpp_f<0x121>(v); return v; }
__device__ __forceinline__ u32x4 pack8(f32x4 a, f32x4 b) { u32x4 w; w.x = pk2(a[0], a[1]); w.y = pk2(a[2], a[3]); w.z = pk2(b[0], b[1]); w.w = pk2(b[2], b[3]); return w; }
__device__ __forceinline__ void unpack8(u32x4 w, f32x4& a, f32x4& b) { a = (f32x4){bflo(w.x), bfhi(w.x), bflo(w.y), bfhi(w.y)}; b = (f32x4){bflo(w.z), bfhi(w.z), bflo(w.w), bfhi(w.w)}; }
#define MFMA16(a, b, c) __builtin_amdgcn_mfma_f32_16x16x32_bf16((a), (b), (c), 0, 0, 0)
typedef short v4i16_t __attribute__((ext_vector_type(4)));
__device__ __forceinline__ v4i16_t lds_tr16(const LAS bf16_t* p) { return __builtin_amdgcn_ds_read_tr16_b64_v4i16((LAS v4i16_t*)p); }
#define LDS_WAIT() asm volatile("s_waitcnt lgkmcnt(0)" ::: "memory")
#define LBAR() do { asm volatile("s_waitcnt lgkmcnt(0)" ::: "memory"); __builtin_amdgcn_s_barrier(); asm volatile("" ::: "memory"); } while (0)

namespace pg8 {
constexpr int BM = 256, BK = 64, HALF = 128, HTB = HALF * BK * 2, STAGE_BYTES = 8 * HTB, NXCD = 8, WGM = 8;
__host__ __device__ __forceinline__ int lds_byte(int r, int c) { const int st = (r >> 4) * 2 + (c >> 5), rr = r & 15, cc = c & 31, ob = rr * 64 + cc * 2; return st * 1024 + (ob ^ (((ob >> 9) & 1) << 5)); }
__host__ __device__ __forceinline__ void stage_rc(int b, int& R, int& C) { const int st = b / 1024, sb = b % 1024, swz = sb ^ (((sb >> 9) & 1) << 5); R = (st >> 1) * 16 + swz / 64; C = (st & 1) * 32 + (swz % 64) / 2; }
__host__ __device__ __forceinline__ int perm32(int rho) { const int n = rho >> 4, i = rho & 15; return 8 * (i >> 2) + 4 * n + (i & 3); }
struct Unit { int pm, pn; };
struct Gemm { const bf16_t* A; int lda; const bf16_t* Bt; int M, N, K; int ajump; };
struct StaticOrder {
    int nM, nN, nwg, G, c;
    __host__ __device__ void init(int M_, int N_, int G_, int c_) { nM = M_ / BM; nN = N_ / BM; nwg = nM * nN; G = G_; c = c_; }
    __host__ __device__ bool next(int i, Unit& u) const {
        const long L = (long)i * G + c; if (L >= nwg) return false;
        int wgid = (int)L; { const int q = nwg / NXCD, r = nwg % NXCD, xcd = wgid % NXCD, off = wgid / NXCD; wgid = (xcd < r ? xcd * (q + 1) : r * (q + 1) + (xcd - r) * q) + off; }
        const int nig = WGM * nN, gid = wgid / nig, fm = gid * WGM, gsz = (nM - fm) < WGM ? (nM - fm) : WGM;
        u.pm = fm + ((wgid % nig) % gsz); u.pn = (wgid % nig) / gsz; return true;
    }
};

template <int MODE> struct Epi {
    static constexpr bool PERM = (MODE != 11 && MODE != 12), AFTER_DRAIN = (MODE == 11 || MODE == 12), MID = (MODE == 13);
    bf16_t* ob; float* of; const bf16_t* gs; bf16_t* gso; bf16_t* out1; LAS unsigned char* lds_top;
    const float *ssqa, *ssqb, *norm_a, *norm_b, *ropec, *ropes;
    const float* nw; unsigned* xbuf; unsigned* cnt; const float* nw2; unsigned* xbuf2; unsigned* cnt2; const float* xin; bf16_t* hn;
    __device__ __forceinline__ void mid(f32x4 (&acc)[2][2][4][2], const Unit& u, int wr, int wc, int fr, int fq) const {
        int zo_ = 0; asm volatile("" : "+v"(zo_));
        const int row0 = u.pm * BM + wr * 64 + fr + zo_, cb = wc * 32 + 8 * fq;
#pragma unroll
        for (int ai = 0; ai < 2; ++ai)
#pragma unroll
            for (int m = 0; m < 4; ++m) { const bf16_t* gp = gs + (size_t)(row0 + ai * HALF + m * 16) * 2048 + u.pn * BM + cb;
#pragma unroll
                for (int bj = 0; bj < 2; ++bj) { f32x4 a0, a1, b0, b1; unpack8(__builtin_nontemporal_load((const u32x4*)(gp + bj * HALF)), a0, a1); unpack8(*(const u32x4*)(gp + 1024 + bj * HALF), b0, b1);
#pragma unroll
                    for (int e = 0; e < 4; ++e) { a0[e] *= __builtin_amdgcn_rcpf(b0[e]); a1[e] *= __builtin_amdgcn_rcpf(b1[e]); }
                    acc[ai][bj][m][0] = acc[ai][bj][m][0] * a0; acc[ai][bj][m][1] = acc[ai][bj][m][1] * a1; }
                asm volatile("" ::: "memory"); }
    }
    __device__ __forceinline__ void row_rstd(const f32x4 (&acc)[2][2][4][2], const Unit& u, int wr, int wc, int fr, int fq, LAS unsigned char* lds, int wid, int lane, unsigned* xb, unsigned* ct) const {
        LAS float* P = (LAS float*)lds;
        LAS float* SR = (LAS float*)(lds + 8192);
#pragma unroll
        for (int ai = 0; ai < 2; ++ai)
#pragma unroll
            for (int m = 0; m < 4; ++m) { float sq = 0.f;
#pragma unroll
                for (int bj = 0; bj < 2; ++bj)
#pragma unroll
                    for (int n = 0; n < 2; ++n) { const f32x4 x = acc[ai][bj][m][n]; sq += (x[0] * x[0] + x[1] * x[1]) + (x[2] * x[2] + x[3] * x[3]); }
                sq += __shfl_xor(sq, 16); sq += __shfl_xor(sq, 32);
                if (fq == 0) P[(ai * HALF + wr * 64 + m * 16 + fr) * 4 + wc] = sq; }
        asm volatile("s_waitcnt lgkmcnt(0)" ::: "memory"); __builtin_amdgcn_s_barrier(); asm volatile("" ::: "memory");
        const int row = wid * 32 + (lane & 31);
        if (lane < 32) { const float tot = (P[row * 4 + 0] + P[row * 4 + 1]) + (P[row * 4 + 2] + P[row * 4 + 3]);
            __hip_atomic_store(xb + ((size_t)(u.pm * BM + row) * 4 + u.pn), __builtin_bit_cast(unsigned, tot), __ATOMIC_RELAXED, __HIP_MEMORY_SCOPE_AGENT); }
        asm volatile("s_waitcnt vmcnt(0)" ::: "memory");
        if (lane == 0) __hip_atomic_fetch_add(ct + 64 * u.pm, 1u, __ATOMIC_RELAXED, __HIP_MEMORY_SCOPE_AGENT);
        if (wid == 0) { unsigned sp_ = 0;
            while ((unsigned)__builtin_amdgcn_readfirstlane(__hip_atomic_load(ct + 64 * u.pm, __ATOMIC_RELAXED, __HIP_MEMORY_SCOPE_AGENT)) < 32u) { __builtin_amdgcn_s_sleep(2); if (++sp_ > (1u << 22)) break; }
            __builtin_amdgcn_fence(__ATOMIC_ACQUIRE, "agent"); }
        asm volatile("s_waitcnt vmcnt(0) lgkmcnt(0)" ::: "memory"); __builtin_amdgcn_s_barrier(); asm volatile("" ::: "memory");
        if (lane < 32) { const unsigned* sl = xb + (size_t)(u.pm * BM + row) * 4; float tot = 0.f;
#pragma unroll
            for (int t = 0; t < 4; ++t) tot += __builtin_bit_cast(float, __hip_atomic_load(sl + t, __ATOMIC_RELAXED, __HIP_MEMORY_SCOPE_AGENT));
            SR[row] = rsqrtf(tot * (1.f / 1024.f) + EPS); }
        asm volatile("s_waitcnt lgkmcnt(0)" ::: "memory"); __builtin_amdgcn_s_barrier(); asm volatile("" ::: "memory");
    }
    __device__ __forceinline__ void fused(f32x4 (&acc)[2][2][4][2], const Unit& u, int wr, int wc, int fr, int fq, LAS unsigned char* lds, int wid, int lane) const {
        const LAS float* SR = (const LAS float*)(lds + 8192);
        const int col0 = u.pn * BM + wc * 32 + 4 * fq;
        if constexpr (MODE == 11) {
            f32x4 pre[4][2][2];
#pragma unroll
            for (int m = 0; m < 4; ++m) { const size_t off = (size_t)(u.pm * BM + wr * 64 + m * 16 + fr) * 1024 + col0;
#pragma unroll
                for (int bj = 0; bj < 2; ++bj)
#pragma unroll
                    for (int n = 0; n < 2; ++n) pre[m][bj][n] = *(const f32x4*)(of + off + bj * HALF + n * 16); }
            row_rstd(acc, u, wr, wc, fr, fq, lds, wid, lane, xbuf, cnt);
#pragma unroll
            for (int ai = 0; ai < 2; ++ai)
#pragma unroll
                for (int m = 0; m < 4; ++m) { const int rl = ai * HALF + wr * 64 + m * 16 + fr; const float rstd = SR[rl]; const size_t off = (size_t)(u.pm * BM + rl) * 1024 + col0;
#pragma unroll
                    for (int bj = 0; bj < 2; ++bj)
#pragma unroll
                        for (int n = 0; n < 2; ++n) { const int cc = bj * HALF + n * 16; const f32x4 w = *(const f32x4*)(nw + col0 + cc);
                            float* o = of + off + cc; const f32x4 bs = ai == 0 ? pre[m][bj][n] : *(const f32x4*)o; *(f32x4*)o = bs + acc[ai][bj][m][n] * rstd * w; }
                    asm volatile("" ::: "memory"); }
        } else {
            f32x4 pre[4][2][2];
#pragma unroll
            for (int m = 0; m < 4; ++m) { const size_t off = (size_t)(u.pm * BM + wr * 64 + m * 16 + fr) * 1024 + col0;
#pragma unroll
                for (int bj = 0; bj < 2; ++bj)
#pragma unroll
                    for (int n = 0; n < 2; ++n) pre[m][bj][n] = *(const f32x4*)(xin + off + bj * HALF + n * 16); }
            row_rstd(acc, u, wr, wc, fr, fq, lds, wid, lane, xbuf, cnt);
#pragma unroll
            for (int ai = 0; ai < 2; ++ai)
#pragma unroll
                for (int m = 0; m < 4; ++m) { const int rl = ai * HALF + wr * 64 + m * 16 + fr; const float rstd = SR[rl]; const size_t off = (size_t)(u.pm * BM + rl) * 1024 + col0;
#pragma unroll
                    for (int bj = 0; bj < 2; ++bj)
#pragma unroll
                        for (int n = 0; n < 2; ++n) { const int cc = bj * HALF + n * 16; const f32x4 w = *(const f32x4*)(nw + col0 + cc);
                            const f32x4 bs = ai == 0 ? pre[m][bj][n] : *(const f32x4*)(xin + off + cc); acc[ai][bj][m][n] = bs + acc[ai][bj][m][n] * rstd * w; }
                    asm volatile("" : "+v"(acc[ai][0][m][0]), "+v"(acc[ai][0][m][1]), "+v"(acc[ai][1][m][0]), "+v"(acc[ai][1][m][1]));
                    asm volatile("" ::: "memory"); }
            row_rstd(acc, u, wr, wc, fr, fq, lds, wid, lane, xbuf2, cnt2);
#pragma unroll
            for (int ai = 0; ai < 2; ++ai)
#pragma unroll
                for (int m = 0; m < 4; ++m) { const int rl = ai * HALF + wr * 64 + m * 16 + fr; const float rstd = SR[rl]; const size_t off = (size_t)(u.pm * BM + rl) * 1024 + col0;
#pragma unroll
                    for (int bj = 0; bj < 2; ++bj)
#pragma unroll
                        for (int n = 0; n < 2; ++n) { const int cc = bj * HALF + n * 16; const f32x4 w = *(const f32x4*)(nw2 + col0 + cc); const f32x4 x1 = acc[ai][bj][m][n];
                            *(f32x4*)(of + off + cc) = x1; const f32x4 t = x1 * rstd * w; u32x2 pkd; pkd.x = pk2(t[0], t[1]); pkd.y = pk2(t[2], t[3]); *(u32x2*)(hn + off + cc) = pkd; }
                    asm volatile("" ::: "memory"); }
        }
    }
    template <bool IS_A> __device__ __forceinline__ void gate_tile(const f32x4 (&acc)[2][2][4][2], int row0, int cb, int pn, int head, int colbase, const float* nw, int pm, int wr, int wc, int fr, int fq) const {
        LAS float* RS = (LAS float*)(lds_top);
        { const int t_ = (wr * 4 + wc) * 64 + fq * 16 + fr;
          if (t_ < 256) { const int row = pm * BM + t_; float s_ = 0.f;
            if (IS_A) { const f32x4* sp = (const f32x4*)(ssqa + ((size_t)row * 8 + head) * 16);
#pragma unroll
                for (int j = 0; j < 4; ++j) { const f32x4 v = __builtin_nontemporal_load(sp + j); s_ += (v[0] + v[1]) + (v[2] + v[3]); } s_ = s_ * (1.f / 256.f); }
            else { const f32x4* sp = (const f32x4*)(ssqb + ((size_t)row * 4 + head) * 32);
#pragma unroll
                for (int j = 0; j < 8; ++j) { const f32x4 v = __builtin_nontemporal_load(sp + j); s_ += (v[0] + v[1]) + (v[2] + v[3]); } s_ = s_ * (1.f / 512.f); }
            RS[t_] = rsqrtf(s_ + EPS); }
          else RS[t_] = nw[t_ - 256 - cb];
          asm volatile("s_waitcnt lgkmcnt(0)" ::: "memory"); __builtin_amdgcn_s_barrier(); asm volatile("" ::: "memory"); }
#pragma unroll
        for (int ai = 0; ai < 2; ++ai)
#pragma unroll
            for (int m = 0; m < 4; ++m) { const int row = row0 + ai * HALF + m * 16;
                const float rstd = RS[ai * HALF + wr * 64 + m * 16 + fr];
#pragma unroll
                for (int bj = 0; bj < 2; ++bj) { bf16_t* pp = out1 + (size_t)row * LDO + colbase + bj * HALF; f32x4 xa, xb; unpack8(*(const u32x4*)pp, xa, xb);
                    const f32x4 w0 = *(const LAS f32x4*)(RS + 256 + bj * HALF + cb), w1 = *(const LAS f32x4*)(RS + 256 + bj * HALF + cb + 4);
                    const f32x4 za = acc[ai][bj][m][0], zb = acc[ai][bj][m][1]; f32x4 ga, gb;
#pragma unroll
                    for (int e = 0; e < 4; ++e) { ga[e] = siluf_(za[e]); gb[e] = siluf_(zb[e]); }
                    *(u32x4*)pp = pack8(xa * rstd * w0 * ga, xb * rstd * w1 * gb); }
                asm volatile("" ::: "memory"); }
    }
    __device__ __forceinline__ void operator()(const f32x4 (&acc)[2][2][4][2], const Unit& u, int wr, int wc, int fr, int fq) const {
        const int row0 = u.pm * BM + wr * 64 + fr, cb = wc * 32 + 8 * fq, pn = u.pn;
        if constexpr (MODE == 1) {
            if (pn < 16 || pn >= 24) {
#pragma unroll
                for (int ai = 0; ai < 2; ++ai)
#pragma unroll
                    for (int m = 0; m < 4; ++m) { const size_t ro = (size_t)(row0 + ai * HALF + m * 16) * LDO + pn * BM + cb;
#pragma unroll
                        for (int bj = 0; bj < 2; ++bj) *(u32x4*)(out1 + ro + bj * HALF) = pack8(acc[ai][bj][m][0], acc[ai][bj][m][1]); }
            } else {
                const float sc = pn >= 20 ? 0.0625f : 1.f;
                int zo_ = 0; asm volatile("" : "+v"(zo_));
                float cf[8];
#pragma unroll
                for (int j = 0; j < 8; ++j) cf[j] = exp2f(-(float)(cb + j + zo_) * (13.287712379549449f / 128.f)) * 0.15915494309189535f;
#pragma unroll
                for (int ai = 0; ai < 2; ++ai)
#pragma unroll
                    for (int m = 0; m < 4; ++m) { const int row = row0 + ai * HALF + m * 16; const size_t ro = (size_t)row * LDO + pn * BM + cb; const float pos = (float)(row & (SEQ - 1));
                        f32x4 c0, c1, s0, s1;
#pragma unroll
                        for (int j = 0; j < 4; ++j) { const float r0_ = __builtin_amdgcn_fractf(pos * cf[j]), r1_ = __builtin_amdgcn_fractf(pos * cf[4 + j]);
                            c0[j] = __builtin_amdgcn_cosf(r0_) * sc; s0[j] = __builtin_amdgcn_sinf(r0_) * sc; c1[j] = __builtin_amdgcn_cosf(r1_) * sc; s1[j] = __builtin_amdgcn_sinf(r1_) * sc; }
                        const f32x4 t1a = acc[ai][0][m][0], t1b = acc[ai][0][m][1], t2a = acc[ai][1][m][0], t2b = acc[ai][1][m][1];
                        *(u32x4*)(out1 + ro) = pack8(t1a * c0 - t2a * s0, t1b * c1 - t2b * s1);
                        *(u32x4*)(out1 + ro + HALF) = pack8(t1a * s0 + t2a * c0, t1b * s1 + t2b * c1); }
            }
        } else if constexpr (MODE == 4) {
            if (pn < 8) gate_tile<true>(acc, row0, cb, pn, pn, pn * BM + cb, norm_a + cb, u.pm, wr, wc, fr, fq);
            else if (pn < 16) gate_tile<false>(acc, row0, cb, pn, (pn - 8) >> 1, 6144 + (pn - 8) * BM + cb, norm_b + (pn - 8) * BM + cb, u.pm, wr, wc, fr, fq);
            else {
#pragma unroll
                for (int ai = 0; ai < 2; ++ai)
#pragma unroll
                    for (int m = 0; m < 4; ++m) { const size_t ro = (size_t)(row0 + ai * HALF + m * 16) * 2048 + (pn - 16) * BM + cb;
#pragma unroll
                        for (int bj = 0; bj < 2; ++bj) { const f32x4 za = acc[ai][bj][m][0], zb = acc[ai][bj][m][1]; f32x4 ga, gb;
#pragma unroll
                            for (int e = 0; e < 4; ++e) { ga[e] = sigmoidf_(za[e]); gb[e] = sigmoidf_(zb[e]); }
                            *(u32x4*)(gso + ro + bj * HALF) = pack8(ga, gb); } }
            }
        } else {
#pragma unroll
            for (int ai = 0; ai < 2; ++ai)
#pragma unroll
                for (int m = 0; m < 4; ++m) { const int row = row0 + ai * HALF + m * 16;
#pragma unroll
                    for (int bj = 0; bj < 2; ++bj) { const int col = pn * BM + bj * HALF + cb; const f32x4 va = acc[ai][bj][m][0], vb = acc[ai][bj][m][1];
                        if constexpr (MODE == 5) { f32x4 ga, gb; unpack8(*(const u32x4*)(gs + (size_t)row * 2048 + col), ga, gb);
                            float* o = of + (size_t)row * 1024 + col; *(f32x4*)o = va * ga; *(f32x4*)(o + 4) = vb * gb; }
                        else if constexpr (MODE == 6) { f32x4 ga, gb; unpack8(*(const u32x4*)(gs + (size_t)row * 2048 + 1024 + col), ga, gb);
                            const float* o = of + (size_t)row * 1024 + col; const f32x4 ta = *(const f32x4*)o, tb = *(const f32x4*)(o + 4);
                            *(u32x4*)(ob + (size_t)row * 1024 + col) = pack8(ta + va * ga, tb + vb * gb); }
                        else if constexpr (MODE == 7) { float* o = of + (size_t)row * 1024 + col; *(f32x4*)o = va; *(f32x4*)(o + 4) = vb; }
                        else if constexpr (MODE == 13) { f32x4 ga, gb; unpack8(__builtin_nontemporal_load((const u32x4*)(gs + (size_t)row * 2048 + 1024 + col)), ga, gb); *(u32x4*)(ob + (size_t)row * 1024 + col) = pack8(va * ga, vb * gb); }
                        else if constexpr (MODE == 9) { f32x4 ra, rb;
#pragma unroll
                            for (int e = 0; e < 4; ++e) { const float a = fmaxf(va[e], 0.f), b = fmaxf(vb[e], 0.f); ra[e] = a * a; rb[e] = b * b; }
                            *(u32x4*)(ob + (size_t)row * 4096 + col) = pack8(ra, rb); }
                    } }
        }
    }
};

template <class EpiT, class Sched, bool ALIGN_EPI>
__device__ __forceinline__ void gemm_phase(LAS unsigned char* lds, const Gemm g, const Sched& S, const EpiT& E) {
    int tid_ = threadIdx.x; asm volatile("" : "+v"(tid_));
    const int tid = tid_, wid = __builtin_amdgcn_readfirstlane(tid >> 6), lane = tid & 63, wr = wid >> 2, wc = wid & 3, fr = lane & 15, fq = lane >> 4;
    const int K = g.K, nt = K / BK, lda = g.lda;
    unsigned voffA[2], voffB[2];
#pragma unroll
    for (int i = 0; i < 2; ++i) { int R, C; stage_rc(tid * 16 + i * 8192, R, C); const int Rb = EpiT::PERM ? ((R & ~31) + perm32(R & 31)) : R;
        voffA[i] = (unsigned)(R * lda + C) * 2u; voffB[i] = (unsigned)(Rb * K + C) * 2u; }
    const size_t kstep = (size_t)(BK * 2);
    const size_t hstepA = (size_t)HALF * lda * 2, hstepB = (size_t)HALF * K * 2;
    const size_t tstepA = 2 * hstepA, tstepB = 2 * hstepB;
    const unsigned ldsw = (unsigned)wid * 1024u;
    const int aoff = lds_byte(wr * 64 + fr, fq * 8), boff = lds_byte(wc * 32 + fr, fq * 8);
#define PG8_SA(b, h) (((b) * 2 + (h)) * HTB)
#define PG8_SB(b, h) ((4 + (b) * 2 + (h)) * HTB)
#define PG8_STAGE(bufoff, gbase, voff) do { _Pragma("unroll") for (int _i = 0; _i < 2; ++_i) \
        __builtin_amdgcn_global_load_lds((const unsigned*)((const char*)(gbase) + (voff)[_i]), (LAS unsigned*)(lds + (bufoff) + ldsw + _i * 8192), 16, 0, 0); } while (0)
#define PG8_LDA(dst, b, h) do { _Pragma("unroll") for (int m = 0; m < 4; ++m) _Pragma("unroll") for (int k = 0; k < 2; ++k) dst[m][k] = *(const LAS bf16x8*)(lds + PG8_SA(b, h) + aoff + m * 2048 + k * 1024); } while (0)
#define PG8_LDB(dst, b, h) do { _Pragma("unroll") for (int n = 0; n < 2; ++n) _Pragma("unroll") for (int k = 0; k < 2; ++k) dst[n][k] = *(const LAS bf16x8*)(lds + PG8_SB(b, h) + boff + n * 2048 + k * 1024); } while (0)
#define PG8_MMA(ai, bj, At, Bt) do { __builtin_amdgcn_s_setprio(1); _Pragma("unroll") for (int m = 0; m < 4; ++m) _Pragma("unroll") for (int n = 0; n < 2; ++n) _Pragma("unroll") for (int k = 0; k < 2; ++k) \
        acc[ai][bj][m][n] = __builtin_amdgcn_mfma_f32_16x16x32_bf16(Bt[n][k], At[m][k], acc[ai][bj][m][n], 0, 0, 0); __builtin_amdgcn_s_setprio(0); } while (0)
#define PG8_WAIT_V(n) asm volatile("s_waitcnt vmcnt(" #n ")" ::: "memory")
#define PG8_WAIT_L(n) asm volatile("s_waitcnt lgkmcnt(" #n ")" ::: "memory")
#define PG8_BAR __builtin_amdgcn_s_barrier()
#define PG8_SCHED __builtin_amdgcn_sched_barrier(0)
    Unit cur, nxt; int ui = 0;
    if (!S.next(0, cur)) return;
    f32x4 acc[2][2][4][2];
#pragma unroll
    for (int a = 0; a < 2; ++a)
#pragma unroll
        for (int b = 0; b < 2; ++b)
#pragma unroll
            for (int m = 0; m < 4; ++m)
#pragma unroll
                for (int n = 0; n < 2; ++n) acc[a][b][m][n] = (f32x4){0.f, 0.f, 0.f, 0.f};
    bf16x8 At[4][2], B0[2][2], B1[2][2];
    const char* cA = (const char*)g.A + (size_t)cur.pm * tstepA; const char* cB = (const char*)g.Bt + (size_t)cur.pn * tstepB;
    PG8_STAGE(PG8_SB(0, 0), cB, voffB); PG8_STAGE(PG8_SB(0, 1), cB + hstepB, voffB); PG8_STAGE(PG8_SA(0, 0), cA, voffA); PG8_STAGE(PG8_SA(0, 1), cA + hstepA, voffA);
    if (wr == 1) PG8_BAR;
    PG8_WAIT_V(2); PG8_BAR;
    PG8_STAGE(PG8_SB(1, 0), cB + kstep, voffB); PG8_STAGE(PG8_SA(1, 0), cA + kstep, voffA); PG8_STAGE(PG8_SB(1, 1), cB + hstepB + kstep, voffB);
    PG8_WAIT_V(6); PG8_BAR;
    for (;;) {
        const bool has_next = S.next(ui + 1, nxt);
        const char* nA = has_next ? (const char*)g.A + (size_t)nxt.pm * tstepA : cA; const char* nB = has_next ? (const char*)g.Bt + (size_t)nxt.pn * tstepB : cB;
        for (int t = 0; t < nt; t += 2) {
            const bool last = (t == nt - 2);
            const size_t aj1 = (EpiT::MID && t + 1 >= nt / 2) ? (size_t)g.ajump : 0, aj2 = (EpiT::MID && t + 2 >= nt / 2) ? (size_t)g.ajump : 0;
            if constexpr (EpiT::MID) { PG8_SCHED; if (t == nt / 2) E.mid(acc, cur, wr, wc, fr, fq); PG8_SCHED; }
            const char* a1 = cA + (size_t)(t + 1) * kstep + aj1;
            const char* a2 = last ? nA : cA + (size_t)(t + 2) * kstep + aj2; const char* b2 = last ? nB : cB + (size_t)(t + 2) * kstep;
            const char* a3 = a2 + kstep; const char* b3 = b2 + kstep;
            PG8_LDB(B0, 0, 0); PG8_LDB(B1, 0, 1); PG8_SCHED; PG8_LDA(At, 0, 0); PG8_STAGE(PG8_SA(1, 1), a1 + hstepA, voffA);
            PG8_WAIT_V(8); PG8_WAIT_L(0); PG8_BAR; PG8_MMA(0, 0, At, B0); PG8_MMA(0, 1, At, B1); PG8_BAR; PG8_SCHED;
            PG8_LDA(At, 0, 1); PG8_STAGE(PG8_SB(0, 0), b2, voffB); PG8_STAGE(PG8_SB(0, 1), b2 + hstepB, voffB); PG8_STAGE(PG8_SA(0, 0), a2, voffA);
            PG8_WAIT_V(8); PG8_WAIT_L(0); PG8_BAR; PG8_MMA(1, 0, At, B0); PG8_MMA(1, 1, At, B1); PG8_BAR; PG8_SCHED;
            PG8_LDB(B0, 1, 0); PG8_LDB(B1, 1, 1); PG8_SCHED; PG8_LDA(At, 1, 0); PG8_STAGE(PG8_SA(0, 1), a2 + hstepA, voffA);
            PG8_WAIT_V(8); PG8_WAIT_L(0); PG8_BAR; PG8_MMA(0, 0, At, B0); PG8_MMA(0, 1, At, B1); PG8_BAR; PG8_SCHED;
            PG8_LDA(At, 1, 1); PG8_STAGE(PG8_SB(1, 0), b3, voffB); PG8_STAGE(PG8_SB(1, 1), b3 + hstepB, voffB); PG8_STAGE(PG8_SA(1, 0), a3, voffA);
            PG8_WAIT_V(8); PG8_WAIT_L(0); PG8_BAR; PG8_MMA(1, 0, At, B0); PG8_MMA(1, 1, At, B1); PG8_BAR; PG8_SCHED;
        }
        if constexpr (ALIGN_EPI) { if (wr == 0) PG8_BAR; }
        if constexpr (!EpiT::AFTER_DRAIN) E(acc, cur, wr, wc, fr, fq);
        if (!has_next) break;
#pragma unroll
        for (int a = 0; a < 2; ++a)
#pragma unroll
            for (int b = 0; b < 2; ++b)
#pragma unroll
                for (int m = 0; m < 4; ++m)
#pragma unroll
                    for (int n = 0; n < 2; ++n) acc[a][b][m][n] = (f32x4){0.f, 0.f, 0.f, 0.f};
        cur = nxt; cA = nA; cB = nB; ++ui;
        if constexpr (ALIGN_EPI) { if (wr == 1) PG8_BAR; }
    }
    PG8_WAIT_V(0);
    if constexpr (!ALIGN_EPI) { if (wr == 0) PG8_BAR; }
    PG8_BAR;
    if constexpr (EpiT::AFTER_DRAIN) E.fused(acc, cur, wr, wc, fr, fq, lds, wid, lane);
#undef PG8_SA
#undef PG8_SB
#undef PG8_STAGE
#undef PG8_LDA
#undef PG8_LDB
#undef PG8_MMA
#undef PG8_WAIT_V
#undef PG8_WAIT_L
#undef PG8_BAR
#undef PG8_SCHED
}
}

__device__ __forceinline__ void transpose_item(const float* W, int ldw, int K, int ncols, bf16_t* WT, int row_off, LAS float* scr, int item, int lane, int ldt = 0, int koff = 0) {
    if (ldt == 0) ldt = K;
    const int nblk = ncols / 32, kb = item / nblk, nb = item % nblk, k0 = 64 * kb, n0 = 32 * nb;
#pragma unroll 8
    for (int i = 0; i < 32; ++i) { const int kk = 2 * i + (lane >> 5); scr[kk * 33 + (lane & 31)] = __builtin_nontemporal_load(W + (size_t)(k0 + kk) * ldw + n0 + (lane & 31)); }
    LDS_WAIT(); asm volatile("" ::: "memory");
    const int c = lane & 7;
#pragma unroll
    for (int j = 0; j < 4; ++j) { const int n = (lane >> 3) + 8 * j; const LAS float* s = scr + (8 * c) * 33 + n;
        u32x4 o; o.x = pk2(s[0 * 33], s[1 * 33]); o.y = pk2(s[2 * 33], s[3 * 33]); o.z = pk2(s[4 * 33], s[5 * 33]); o.w = pk2(s[6 * 33], s[7 * 33]);
        *(u32x4*)(WT + (size_t)(row_off + n0 + n) * ldt + koff + k0 + 8 * c) = o; }
    LDS_WAIT(); asm volatile("" ::: "memory");
}

__device__ __forceinline__ void prologue(const Params& p, LAS unsigned char* lds) {
    int tid_ = threadIdx.x; asm volatile("" : "+v"(tid_)); const int tid = tid_, lane = tid & 63, wave = tid >> 6;
    const int gw = blockIdx.x * NWAVES + wave, NGW = gridDim.x * NWAVES;
    unsigned char* ws = p.ws;
    LAS float* scr = (LAS float*)(lds + wave * 9216);
    LAS float* WBT = (LAS float*)(lds + 81856);
    for (int i = tid; i < 1024 * 16; i += NTHREADS) WBT[(i & 15) * 1024 + (i >> 4)] = p.w_in[(size_t)(i >> 4) * DIN + 6144 + (i & 15)];
    constexpr int I1 = 16 * 128, I3 = 16 * 64, I6 = 32 * 32, I8 = 16 * 32, I9 = 16 * 128, I10 = 64 * 32;
    constexpr int NITEMS = 2 * I1 + 3 * I3 + 2 * I6 + I8 + I9 + I10;
    for (int it = gw; it < NITEMS; it += NGW) {
        int r = it;
        if (r < I1) { transpose_item(p.w_in, DIN, 1024, 4096, (bf16_t*)(ws + WS_W1A), 0, scr, r, lane); continue; } r -= I1;
        if (r < I1) { transpose_item(p.w_in + 6160, DIN, 1024, 4096, (bf16_t*)(ws + WS_W1A), 4096, scr, r, lane); continue; } r -= I1;
        if (r < I3) { transpose_item(p.w_in + 4096, DIN, 1024, 2048, (bf16_t*)(ws + WS_W1B), 0, scr, r, lane); continue; } r -= I3;
        if (r < I3) { transpose_item(p.w_in + 10256, DIN, 1024, 2048, (bf16_t*)(ws + WS_W1B), 2048, scr, r, lane); continue; } r -= I3;
        if (r < I3) { transpose_item(p.w_in + 12304, DIN, 1024, 2048, (bf16_t*)(ws + WS_W1B), 4096, scr, r, lane); continue; } r -= I3;
        if (r < I6) { transpose_item(p.w_br_a, 1024, 2048, 1024, (bf16_t*)(ws + WS_WBRA), 0, scr, r, lane, 4096, 0); continue; } r -= I6;
        if (r < I6) { transpose_item(p.w_br_b, 1024, 2048, 1024, (bf16_t*)(ws + WS_WBRA), 0, scr, r, lane, 4096, 2048); continue; } r -= I6;
        if (r < I8) { transpose_item(p.w_out, 1024, 1024, 1024, (bf16_t*)(ws + WS_WOUT), 0, scr, r, lane); continue; } r -= I8;
        if (r < I9) { transpose_item(p.w_up, 4096, 1024, 4096, (bf16_t*)(ws + WS_WUP), 0, scr, r, lane); continue; } r -= I9;
        transpose_item(p.w_down, 1024, 4096, 1024, (bf16_t*)(ws + WS_WDN), 0, scr, r, lane);
    }
    __syncthreads();
    {
        bf16_t* XN = (bf16_t*)(ws + WS_XN); float* BETA = (float*)(ws + WS_BETA); float* GG = (float*)(ws + WS_GG);
        f32x4 nw[4];
#pragma unroll
        for (int j = 0; j < 4; ++j) nw[j] = *((const f32x4*)p.n_mix_pre + lane + 64 * j);
        const float alog = p.a_log[lane & 7], dtb = p.dt_bias[lane & 7];
        for (int m = gw; m < M; m += NGW) {
            const f32x4* xr = (const f32x4*)(p.x + (size_t)m * D) + lane;
            f32x4 v[4]; float s = 0.f;
#pragma unroll
            for (int j = 0; j < 4; ++j) { v[j] = __builtin_nontemporal_load(xr + 64 * j); s += (v[j][0] * v[j][0] + v[j][1] * v[j][1]) + (v[j][2] * v[j][2] + v[j][3] * v[j][3]); }
            const float rstd = rsqrtf(wave_sum(s) * (1.f / D) + EPS);
            unsigned long long* o8 = (unsigned long long*)(XN + (size_t)m * D) + lane;
            float ac[16];
#pragma unroll
            for (int c = 0; c < 16; ++c) ac[c] = 0.f;
#pragma unroll
            for (int j = 0; j < 4; ++j) { v[j] = v[j] * rstd * nw[j];
                o8[64 * j] = (unsigned long long)pk2(v[j][0], v[j][1]) | ((unsigned long long)pk2(v[j][2], v[j][3]) << 32);
#pragma unroll
                for (int c = 0; c < 16; ++c) { const f32x4 w = *(const LAS f32x4*)(WBT + c * 1024 + 256 * j + 4 * lane); ac[c] += (v[j][0] * w[0] + v[j][1] * w[1]) + (v[j][2] * w[2] + v[j][3] * w[3]); }
                asm volatile("" ::: "memory"); }
            float mine = 0.f;
#pragma unroll
            for (int c = 0; c < 16; ++c) { const float t = row16_sum(ac[c]); mine = ((lane & 15) == c) ? t : mine; }
            mine += __shfl_xor(mine, 16); mine += __shfl_xor(mine, 32);
            if (lane < 8) BETA[(size_t)m * 8 + lane] = sigmoidf_(mine);
            else if (lane < 16) { const float z = mine + dtb; const float sp = fmaxf(z, 0.f) + log1pf(__expf(-fabsf(z))); GG[(size_t)m * 8 + (lane - 8)] = -__expf(alog) * sp; }
        }
    }
}

__device__ __forceinline__ void prepA_item(const Params& p, LAS unsigned char* lds, int half, int item, int slot) {
    int tid_ = threadIdx.x; asm volatile("" : "+v"(tid_)); const int tid = tid_, lane = tid & 63, w = tid >> 6, r = lane & 15, q = lane >> 4;
    const int bh = item >> 7, n = item & 127, bl = bh >> 3, h = bh & 7;
    const int rowh = bl * SEQ + n * 64;
    const size_t growb = (size_t)half * MH + rowh;
    unsigned char* ws = p.ws;
    const bf16_t* out1 = (const bf16_t*)(ws + WS_OUT1);
    bf16_t* QKN = (bf16_t*)(ws + WS_QKN); bf16_t* TA = (bf16_t*)(ws + WS_TA) + (size_t)item * 8192; float* GC = (float*)(ws + WS_GC);
    LAS bf16_t* QN = (LAS bf16_t*)lds;
    LAS bf16_t* KN = (LAS bf16_t*)(lds + 17408);
    LAS float* LM = (LAS float*)(lds + 34816 + slot * 17152);
    LAS float* GCS = LM + 64 * 65;
    LAS float* BTS = GCS + 64;
    {
        const int piece = tid & 31, rg = tid >> 5, mat = piece >> 4, col0 = 8 * (piece & 15);
        const int ch = mat * 1024 + h * 128 + col0;
        f32x4 wa[4], wb[4];
#pragma unroll
        for (int j = 0; j < 4; ++j) { wa[j] = *(const f32x4*)(p.conv_a + j * 4096 + ch); wb[j] = *(const f32x4*)(p.conv_a + j * 4096 + ch + 4); }
        const bf16_t* src = out1 + (size_t)rowh * LDO + ch;
        u32x4 xr[7];
#pragma unroll
        for (int j = 0; j < 7; ++j) { const int rr = rg * 4 - 3 + j; xr[j] = __builtin_nontemporal_load((const u32x4*)(src + (ptrdiff_t)((n * 64 + rr < 0) ? 0 : rr) * LDO)); }
        f32x4 xa[7], xb[7];
#pragma unroll
        for (int j = 0; j < 7; ++j) { unpack8(xr[j], xa[j], xb[j]); if (n * 64 + rg * 4 - 3 + j < 0) { xa[j] = (f32x4){0.f, 0.f, 0.f, 0.f}; xb[j] = (f32x4){0.f, 0.f, 0.f, 0.f}; } }
#pragma unroll
        for (int i = 0; i < 4; ++i) { f32x4 ya = wa[0] * xa[i] + wa[1] * xa[i + 1] + wa[2] * xa[i + 2] + wa[3] * xa[i + 3], yb = wb[0] * xb[i] + wb[1] * xb[i + 1] + wb[2] * xb[i + 2] + wb[3] * xb[i + 3];
#pragma unroll
            for (int e = 0; e < 4; ++e) { ya[e] = siluf_(ya[e]); yb[e] = siluf_(yb[e]); }
            const float ss = row16_sum((ya[0] * ya[0] + ya[1] * ya[1]) + (ya[2] * ya[2] + ya[3] * ya[3]) + (yb[0] * yb[0] + yb[1] * yb[1]) + (yb[2] * yb[2] + yb[3] * yb[3]));
            const float inv = rsqrtf(ss + EPS) * (mat == 0 ? 0.08838834764831845f : 1.f);
            const u32x4 o = pack8(ya * inv, yb * inv); const int c = rg * 4 + i;
            *(LAS u32x4*)((mat == 0 ? QN : KN) + c * 136 + col0) = o;
            *(u32x4*)(QKN + (size_t)(rowh + c) * 2048 + mat * 1024 + h * 128 + col0) = o;
            asm volatile("" ::: "memory"); }
    }
    if (w == 0) {
        float g = ((const float*)(ws + WS_GG))[(growb + lane) * 8 + h];
#pragma unroll
        for (int o = 1; o < 64; o <<= 1) { const float t = __shfl_up(g, o); if (lane >= o) g += t; }
        GCS[lane] = g; GC[((size_t)rowh + lane) * 8 + h] = g;
        BTS[lane] = ((const float*)(ws + WS_BETA))[(growb + lane) * 8 + h];
    }
    __syncthreads();
    {
        const int which = w >> 2, mt = w & 3;
        const LAS bf16_t* Ab = (which ? QN : KN) + (16 * mt + r) * 136 + 8 * q;
        f32x4 acc[4];
#pragma unroll
        for (int nt = 0; nt < 4; ++nt) acc[nt] = (f32x4){0.f, 0.f, 0.f, 0.f};
#pragma unroll
        for (int ks = 0; ks < 4; ++ks) { const bf16x8 a = *(const LAS bf16x8*)(Ab + 32 * ks);
#pragma unroll
            for (int nt = 0; nt < 4; ++nt) { const bf16x8 b = *(const LAS bf16x8*)(KN + (16 * nt + r) * 136 + 32 * ks + 8 * q); acc[nt] = MFMA16(a, b, acc[nt]); } }
#pragma unroll
        for (int nt = 0; nt < 4; ++nt) { const int mcol = 16 * nt + r; const float gm = GCS[mcol];
#pragma unroll
            for (int i = 0; i < 4; ++i) { const int c = 16 * mt + 4 * q + i; const float dec = __expf(GCS[c] - gm);
                if (which == 0) LM[c * 65 + mcol] = (c > mcol) ? BTS[c] * acc[nt][i] * dec : 0.f;
                else TA[4096 + c * 64 + mcol] = (bf16_t)f2bf((c >= mcol) ? acc[nt][i] * dec : 0.f); } }
    }
    __syncthreads();
}
__device__ __forceinline__ void prepA_invert(const Params& p, LAS unsigned char* lds, int item, int slot) {
    int tid_ = threadIdx.x; asm volatile("" : "+v"(tid_)); const int lane = tid_ & 63;
    bf16_t* TA = (bf16_t*)(p.ws + WS_TA) + (size_t)item * 8192;
    const LAS float* LM = (const LAS float*)(lds + 34816 + slot * 17152);
    const LAS float* BTS = LM + 64 * 65 + 64;
    float t[64]; const float bt = BTS[lane];
#pragma unroll
    for (int i = 0; i < 64; ++i) {
        asm volatile("" ::: "memory");
        const float lrow = LM[i * 65 + lane];
        float a0 = (lane == i) ? 1.f : 0.f, a1 = 0.f;
#pragma unroll
        for (int j = 0; j < i; ++j) { const float l = __builtin_bit_cast(float, __builtin_amdgcn_readlane(__builtin_bit_cast(int, lrow), j));
            if (j & 1) a1 -= l * t[j]; else a0 -= l * t[j]; }
        t[i] = a0 + a1;
        TA[i * 64 + lane] = (bf16_t)f2bf(t[i] * bt);
    }
}

__device__ __forceinline__ void prepB_wave(const Params& p, int item, int mt) {
    int tid_ = threadIdx.x; asm volatile("" : "+v"(tid_)); const int lane = tid_ & 63, r = lane & 15, q = lane >> 4;
    const int bh = item >> 7, n = item & 127, bl = bh >> 2, h = bh & 3;
    const int rowh = bl * SEQ + n * 64;
    const bf16_t* out1 = (const bf16_t*)(p.ws + WS_OUT1);
    bf16_t* SC = (bf16_t*)(p.ws + WS_SC) + (size_t)item * 4096;
    const bf16_t* qb = out1 + (size_t)(rowh + 16 * mt + r) * LDO + 4096 + h * 256 + 8 * q;
    const bf16_t* kb = out1 + (size_t)(rowh + r) * LDO + 5120 + h * 256 + 8 * q;
    f32x4 acc[4];
#pragma unroll
    for (int nt = 0; nt < 4; ++nt) acc[nt] = (f32x4){0.f, 0.f, 0.f, 0.f};
#pragma unroll 2
    for (int ks = 0; ks < 8; ++ks) { const bf16x8 a = *(const bf16x8*)(qb + 32 * ks);
#pragma unroll
        for (int nt = 0; nt < 4; ++nt) { const bf16x8 b = *(const bf16x8*)(kb + (size_t)(16 * nt) * LDO + 32 * ks); acc[nt] = MFMA16(a, b, acc[nt]); } }
    const float lg = log1pf(-exp2f(-5.f - (float)h));
#pragma unroll
    for (int nt = 0; nt < 4; ++nt) { const int mcol = 16 * nt + r;
#pragma unroll
        for (int i = 0; i < 4; ++i) { const int c = 16 * mt + 4 * q + i; const int d = c > mcol ? c - mcol : mcol - c;
            SC[c * 64 + mcol] = (bf16_t)f2bf(acc[nt][i] * __expf(lg * (float)d)); } }
}

__device__ __forceinline__ u32x2 pk4(f32x4 v) { u32x2 o; o.x = pk2(v[0], v[1]); o.y = pk2(v[2], v[3]); return o; }

__device__ __forceinline__ void scanA(const Params& p, LAS unsigned char* lds, int half, int pair, int slice) {
    int tid_ = threadIdx.x; asm volatile("" : "+v"(tid_)); const int tid = tid_, lane = tid & 63, w = tid >> 6, r = lane & 15, q = lane >> 4;
    const int bl = pair >> 3, h = pair & 7;
    unsigned char* ws = p.ws;
    bf16_t* out1 = (bf16_t*)(ws + WS_OUT1);
    const bf16_t* QKN = (const bf16_t*)(ws + WS_QKN); const bf16_t* TAb = (const bf16_t*)(ws + WS_TA) + (size_t)(pair * 128) * 8192; const float* GC = (const float*)(ws + WS_GC);
    float* SSQ = (float*)(ws + WS_SSQA);
    LAS bf16_t* KS = (LAS bf16_t*)lds;
    LAS bf16_t* QS = (LAS bf16_t*)(lds + 17408);
    LAS bf16_t* TS = (LAS bf16_t*)(lds + 34816);
    LAS bf16_t* AS = (LAS bf16_t*)(lds + 44032);
    LAS float* VT = (LAS float*)(lds + 53248);
    LAS bf16_t* ST = (LAS bf16_t*)(lds + 61952);
    LAS bf16_t* RT = (LAS bf16_t*)(lds + 70656);
    LAS bf16_t* VN = (LAS bf16_t*)(lds + 75264);
    LAS bf16_t* VD = (LAS bf16_t*)(lds + 79872);
    LAS float* EG = (LAS float*)(lds + 84480);
    LAS float* EK = (LAS float*)(lds + 84736);
    const int mt = w & 3, nt = w >> 2;
    const int vcp = tid & 15, vrg = tid >> 4;
    const int vch = 2048 + h * 256 + slice * 32 + 2 * vcp;
    const float cw0 = p.conv_a[vch], cw1 = p.conv_a[4096 + vch], cw2 = p.conv_a[8192 + vch], cw3 = p.conv_a[12288 + vch];
    const float dw0 = p.conv_a[vch + 1], dw1 = p.conv_a[4096 + vch + 1], dw2 = p.conv_a[8192 + vch + 1], dw3 = p.conv_a[12288 + vch + 1];
    f32x4 S[2] = {(f32x4){0.f, 0.f, 0.f, 0.f}, (f32x4){0.f, 0.f, 0.f, 0.f}};
    u32x4 pk[2][2], pq[2][2], pt[2], pa[2]; unsigned xv[2][5]; float pg[2] = {0.f, 0.f};
#define SA_LOAD(nn, s) do { const int rowc = bl * SEQ + (nn) * 64; \
        _Pragma("unroll") for (int i = 0; i < 2; ++i) { const int ch = tid + NTHREADS * i, rr = ch >> 4, cc = ch & 15; const bf16_t* s_ = QKN + (size_t)(rowc + rr) * 2048 + h * 128 + 8 * cc; pq[s][i] = *(const u32x4*)s_; pk[s][i] = *(const u32x4*)(s_ + 1024); } \
        { const bf16_t* t_ = TAb + (size_t)(nn) * 8192 + tid * 8; pt[s] = *(const u32x4*)t_; pa[s] = *(const u32x4*)(t_ + 4096); } \
        pg[s] = GC[((size_t)rowc + (tid & 63)) * 8 + h]; \
        { _Pragma("unroll") for (int j = 0; j < 5; ++j) { const int pos = (nn) * 64 + vrg * 2 - 3 + j; xv[s][j] = __builtin_nontemporal_load((const unsigned*)(out1 + (size_t)(bl * SEQ + (pos < 0 ? 0 : pos)) * LDO + vch)); } } } while (0)
#define SA_STORE(nn, s) do { \
        _Pragma("unroll") for (int i = 0; i < 2; ++i) { const int ch = tid + NTHREADS * i, rr = ch >> 4, cc = ch & 15; *(LAS u32x4*)(QS + rr * 136 + 8 * cc) = pq[s][i]; *(LAS u32x4*)(KS + rr * 136 + 8 * cc) = pk[s][i]; } \
        { const int rr = tid >> 3, cc = tid & 7; *(LAS u32x4*)(TS + rr * 72 + 8 * cc) = pt[s]; *(LAS u32x4*)(AS + rr * 72 + 8 * cc) = pa[s]; } \
        if (tid < 64) { const float gl = __shfl(pg[s], 63); EG[tid] = __expf(pg[s]); EK[tid] = __expf(gl - pg[s]); } \
        { float xf[5], xg[5]; _Pragma("unroll") for (int j = 0; j < 5; ++j) { const bool ok = ((nn) * 64 + vrg * 2 - 3 + j >= 0); xf[j] = ok ? bflo(xv[s][j]) : 0.f; xg[j] = ok ? bfhi(xv[s][j]) : 0.f; } \
            float y[2], z[2]; _Pragma("unroll") for (int i = 0; i < 2; ++i) { y[i] = siluf_(cw0 * xf[i] + cw1 * xf[i + 1] + cw2 * xf[i + 2] + cw3 * xf[i + 3]); z[i] = siluf_(dw0 * xg[i] + dw1 * xg[i + 1] + dw2 * xg[i + 2] + dw3 * xg[i + 3]); } \
            typedef float f32x2_ __attribute__((ext_vector_type(2))); \
            *(LAS f32x2_*)(VT + (2 * vcp) * 68 + vrg * 2) = (f32x2_){y[0], y[1]}; *(LAS f32x2_*)(VT + (2 * vcp + 1) * 68 + vrg * 2) = (f32x2_){z[0], z[1]}; } } while (0)
    SA_LOAD(0, 0);
    for (int i = tid; i < 32 * 136 / 2; i += NTHREADS) ((LAS unsigned*)ST)[i] = 0u;
    SA_STORE(0, 0);
    SA_LOAD(1, 1);
    LBAR();
#define SA_STEP(n, s) do { \
        { const int nn_ = (n) + 2 < 128 ? (n) + 2 : 127; SA_LOAD(nn_, s); } \
        const int c0 = 16 * mt + 4 * q; \
          \
        bf16x8 fa[4], fb[4], fq[4]; \
        _Pragma("unroll") for (int ks = 0; ks < 4; ++ks) { fa[ks] = *(const LAS bf16x8*)(KS + (16 * mt + r) * 136 + 32 * ks + 8 * q); fb[ks] = *(const LAS bf16x8*)(ST + (16 * nt + r) * 136 + 32 * ks + 8 * q); } \
        const f32x4 eg = *(const LAS f32x4*)(EG + c0); \
        const f32x4 vv = *(const LAS f32x4*)(VT + (16 * nt + r) * 68 + c0); \
        _Pragma("unroll") for (int ks = 0; ks < 4; ++ks) fq[ks] = *(const LAS bf16x8*)(QS + (16 * mt + r) * 136 + 32 * ks + 8 * q); \
        __builtin_amdgcn_sched_barrier(0); \
        { f32x4 acc = (f32x4){0.f, 0.f, 0.f, 0.f}; \
          __builtin_amdgcn_s_setprio(1); _Pragma("unroll") for (int ks = 0; ks < 4; ++ks) acc = MFMA16(fa[ks], fb[ks], acc); __builtin_amdgcn_s_setprio(0); \
          *(LAS u32x2*)(RT + (16 * nt + r) * 72 + c0) = pk4(vv - eg * acc); } \
        f32x4 aq = (f32x4){0.f, 0.f, 0.f, 0.f}; \
        _Pragma("unroll") for (int ks = 0; ks < 4; ++ks) aq = MFMA16(fq[ks], fb[ks], aq);     \
        LBAR(); \
          \
        { bf16x8 ta[2], tb[2]; \
          _Pragma("unroll") for (int ks = 0; ks < 2; ++ks) { ta[ks] = *(const LAS bf16x8*)(TS + (16 * mt + r) * 72 + 32 * ks + 8 * q); tb[ks] = *(const LAS bf16x8*)(RT + (16 * nt + r) * 72 + 32 * ks + 8 * q); } \
          const f32x4 ek = *(const LAS f32x4*)(EK + c0); \
          __builtin_amdgcn_sched_barrier(0); \
          f32x4 acc = (f32x4){0.f, 0.f, 0.f, 0.f}; \
          __builtin_amdgcn_s_setprio(1); _Pragma("unroll") for (int ks = 0; ks < 2; ++ks) acc = MFMA16(ta[ks], tb[ks], acc); __builtin_amdgcn_s_setprio(0); \
          *(LAS u32x2*)(VN + (16 * nt + r) * 72 + c0) = pk4(acc); \
          *(LAS u32x2*)(VD + (16 * nt + r) * 72 + c0) = pk4(acc * ek); } \
        LBAR(); \
          \
        { bf16x8 ua[2], ub[2], ga[2], gb[2][2]; \
          _Pragma("unroll") for (int ks = 0; ks < 2; ++ks) { ua[ks] = *(const LAS bf16x8*)(AS + (16 * mt + r) * 72 + 32 * ks + 8 * q); ub[ks] = *(const LAS bf16x8*)(VN + (16 * nt + r) * 72 + 32 * ks + 8 * q); } \
          _Pragma("unroll") for (int ks = 0; ks < 2; ++ks) { \
            _Pragma("unroll") for (int t_ = 0; t_ < 2; ++t_) { const v4i16_t tv = lds_tr16(KS + (32 * ks + 8 * q + 4 * t_ + (r >> 2)) * 136 + 16 * w + 4 * (r & 3)); ga[ks][4 * t_] = tv[0]; ga[ks][4 * t_ + 1] = tv[1]; ga[ks][4 * t_ + 2] = tv[2]; ga[ks][4 * t_ + 3] = tv[3]; }     \
            _Pragma("unroll") for (int n2 = 0; n2 < 2; ++n2) gb[ks][n2] = *(const LAS bf16x8*)(VD + (16 * n2 + r) * 72 + 32 * ks + 8 * q); } \
          const float ld = EG[63]; \
          __builtin_amdgcn_sched_barrier(0); \
          f32x4 aa = (f32x4){0.f, 0.f, 0.f, 0.f}; \
          _Pragma("unroll") for (int ks = 0; ks < 2; ++ks) aa = MFMA16(ua[ks], ub[ks], aa); \
          S[0] = S[0] * ld; S[1] = S[1] * ld; \
          __builtin_amdgcn_s_setprio(1); _Pragma("unroll") for (int ks = 0; ks < 2; ++ks) { \
            _Pragma("unroll") for (int n2 = 0; n2 < 2; ++n2) S[n2] = MFMA16(ga[ks], gb[ks][n2], S[n2]); } __builtin_amdgcn_s_setprio(0); \
          const f32x4 o = eg * aq + aa; \
          const int rowc = bl * SEQ + (n) * 64 + c0; \
          bf16_t* od = out1 + (size_t)rowc * LDO + h * 256 + slice * 32 + 16 * nt + r; \
          f32x4 sq = o * o; \
          _Pragma("unroll") for (int i = 0; i < 4; ++i) od[(size_t)i * LDO] = (bf16_t)f2bf(o[i]); \
          _Pragma("unroll") for (int i = 0; i < 4; ++i) sq[i] = row16_sum(sq[i]); \
          if (r == 0) { \
            _Pragma("unroll") for (int i = 0; i < 4; ++i) SSQ[((size_t)(rowc + i) * 8 + h) * 16 + slice * 2 + nt] = sq[i]; } \
        } \
        LBAR(); \
          \
        _Pragma("unroll") for (int n2 = 0; n2 < 2; ++n2) *(LAS u32x2*)(ST + (16 * n2 + r) * 136 + 16 * w + 4 * q) = pk4(S[n2]); \
        if ((n) + 1 < 128) SA_STORE((n) + 1, 1 - (s)); \
        LBAR(); \
    } while (0)
    for (int n = 0; n < 128; n += 2) { SA_STEP(n, 0); SA_STEP(n + 1, 1); }
#undef SA_STEP
#undef SA_LOAD
#undef SA_STORE
}

__device__ __forceinline__ void scanB(const Params& p, LAS unsigned char* lds, int pair, int slice) {
    int tid_ = threadIdx.x; asm volatile("" : "+v"(tid_)); const int tid = tid_, lane = tid & 63, w = tid >> 6, r = lane & 15, q = lane >> 4;
    const int bl = pair >> 2, h = pair & 3;
    unsigned char* ws = p.ws;
    bf16_t* out1 = (bf16_t*)(ws + WS_OUT1);
    const bf16_t* SCb = (const bf16_t*)(ws + WS_SC) + (size_t)(pair * 128) * 4096;
    float* SSQ = (float*)(ws + WS_SSQB);
    LAS bf16_t* QS = (LAS bf16_t*)lds;
    LAS bf16_t* KS = (LAS bf16_t*)(lds + 33792);
    LAS bf16_t* SS = (LAS bf16_t*)(lds + 67584);
    LAS bf16_t* VT = (LAS bf16_t*)(lds + 76800);
    LAS bf16_t* VD = (LAS bf16_t*)(lds + 81408);
    LAS bf16_t* ST = (LAS bf16_t*)(lds + 86016);
    const float lg = log1pf(-exp2f(-5.f - (float)h));
    const float cd = __expf(lg * 64.f);
    const int mt = w & 3, nt = w >> 2, c0 = 16 * mt + 4 * q;
    f32x4 qd;
#pragma unroll
    for (int i = 0; i < 4; ++i) qd[i] = __expf(lg * (float)(c0 + i + 1));
    const int vrow = tid >> 3, vpart = tid & 7;
    const float kdv = __expf(lg * (float)(63 - vrow));
    const int vcolg = 6144 + h * 512 + slice * 32;
    f32x4 S[2][2];
#pragma unroll
    for (int a = 0; a < 2; ++a)
#pragma unroll
        for (int b = 0; b < 2; ++b) S[a][b] = (f32x4){0.f, 0.f, 0.f, 0.f};
    u32x4 pq[1][4], pk[1][4], ps[1]; u32x2 pv[1];
#define SB_LOAD(nn, s) do { const int rowc = bl * SEQ + (nn) * 64; \
        _Pragma("unroll") for (int i = 0; i < 4; ++i) { const int ch = tid + NTHREADS * i, rr = ch >> 5, cc = ch & 31; const bf16_t* s_ = out1 + (size_t)(rowc + rr) * LDO + 4096 + h * 256 + 8 * cc; pq[s][i] = *(const u32x4*)s_; pk[s][i] = *(const u32x4*)(s_ + 1024); } \
        ps[s] = *(const u32x4*)(SCb + (size_t)(nn) * 4096 + tid * 8); \
        pv[s] = __builtin_nontemporal_load((const u32x2*)(out1 + (size_t)(rowc + vrow) * LDO + vcolg + 4 * vpart)); } while (0)
#define SB_STORE(s) do { \
        _Pragma("unroll") for (int i = 0; i < 4; ++i) { const int ch = tid + NTHREADS * i, rr = ch >> 5, cc = ch & 31; *(LAS u32x4*)(QS + rr * 264 + 8 * cc) = pq[s][i]; *(LAS u32x4*)(KS + rr * 264 + 8 * cc) = pk[s][i]; } \
        { const int rr = tid >> 3, cc = tid & 7; *(LAS u32x4*)(SS + rr * 72 + 8 * cc) = ps[s]; } \
        { const unsigned wv[2] = {pv[s].x, pv[s].y}; _Pragma("unroll") for (int j = 0; j < 2; ++j) { const unsigned d_ = pk2(bflo(wv[j]) * kdv, bfhi(wv[j]) * kdv); \
            VT[(4 * vpart + 2 * j) * 72 + vrow] = (bf16_t)(wv[j] & 0xffffu); VT[(4 * vpart + 2 * j + 1) * 72 + vrow] = (bf16_t)(wv[j] >> 16); \
            VD[(4 * vpart + 2 * j) * 72 + vrow] = (bf16_t)(d_ & 0xffffu); VD[(4 * vpart + 2 * j + 1) * 72 + vrow] = (bf16_t)(d_ >> 16); } } } while (0)
    SB_LOAD(0, 0);
    for (int i = tid; i < 32 * 264 / 2; i += NTHREADS) ((LAS unsigned*)ST)[i] = 0u;
    SB_STORE(0);
    LBAR();
#define SB_STEP(n, s) do { \
        { const int nn_ = (n) + 1 < 128 ? (n) + 1 : 127; SB_LOAD(nn_, 0); } \
        { bf16x8 fa[8], fb[8], sa[2], sb[2], ga[2][2], gb[2][2]; \
          _Pragma("unroll") for (int ks = 0; ks < 8; ++ks) { fa[ks] = *(const LAS bf16x8*)(QS + (16 * mt + r) * 264 + 32 * ks + 8 * q); fb[ks] = *(const LAS bf16x8*)(ST + (16 * nt + r) * 264 + 32 * ks + 8 * q); } \
          _Pragma("unroll") for (int ks = 0; ks < 2; ++ks) { sa[ks] = *(const LAS bf16x8*)(SS + (16 * mt + r) * 72 + 32 * ks + 8 * q); sb[ks] = *(const LAS bf16x8*)(VT + (16 * nt + r) * 72 + 32 * ks + 8 * q); } \
          __builtin_amdgcn_sched_barrier(0); \
          f32x4 a1 = (f32x4){0.f, 0.f, 0.f, 0.f}, a2 = (f32x4){0.f, 0.f, 0.f, 0.f}; \
          _Pragma("unroll") for (int ks = 0; ks < 8; ++ks) a1 = MFMA16(fa[ks], fb[ks], a1); \
          _Pragma("unroll") for (int ks = 0; ks < 2; ++ks) a2 = MFMA16(sa[ks], sb[ks], a2); \
          __builtin_amdgcn_sched_barrier(0); \
          _Pragma("unroll") for (int ks = 0; ks < 2; ++ks) { \
            _Pragma("unroll") for (int n2 = 0; n2 < 2; ++n2) gb[ks][n2] = *(const LAS bf16x8*)(VD + (16 * n2 + r) * 72 + 32 * ks + 8 * q); \
            _Pragma("unroll") for (int m2 = 0; m2 < 2; ++m2) { \
              _Pragma("unroll") for (int t_ = 0; t_ < 2; ++t_) { const v4i16_t tv = lds_tr16(KS + (32 * ks + 8 * q + 4 * t_ + (r >> 2)) * 264 + 32 * w + 16 * m2 + 4 * (r & 3)); ga[m2][ks][4 * t_] = tv[0]; ga[m2][ks][4 * t_ + 1] = tv[1]; ga[m2][ks][4 * t_ + 2] = tv[2]; ga[m2][ks][4 * t_ + 3] = tv[3]; } } } \
          __builtin_amdgcn_sched_barrier(0); \
          _Pragma("unroll") for (int m2 = 0; m2 < 2; ++m2) { S[m2][0] = S[m2][0] * cd; S[m2][1] = S[m2][1] * cd; \
            _Pragma("unroll") for (int ks = 0; ks < 2; ++ks) { \
              _Pragma("unroll") for (int n2 = 0; n2 < 2; ++n2) S[m2][n2] = MFMA16(ga[m2][ks], gb[ks][n2], S[m2][n2]); } } \
          const f32x4 o = qd * a1 + a2; \
          const int rowc = bl * SEQ + (n) * 64 + c0; \
          bf16_t* od = out1 + (size_t)rowc * LDO + vcolg + 16 * nt + r; \
          f32x4 sq = o * o; \
          _Pragma("unroll") for (int i = 0; i < 4; ++i) od[(size_t)i * LDO] = (bf16_t)f2bf(o[i]); \
          _Pragma("unroll") for (int i = 0; i < 4; ++i) sq[i] = row16_sum(sq[i]); \
          if (r == 0) { \
            _Pragma("unroll") for (int i = 0; i < 4; ++i) SSQ[((size_t)(rowc + i) * 4 + h) * 32 + slice * 2 + nt] = sq[i]; } \
        } \
        LBAR(); \
        _Pragma("unroll") for (int m2 = 0; m2 < 2; ++m2) { \
          _Pragma("unroll") for (int n2 = 0; n2 < 2; ++n2) *(LAS u32x2*)(ST + (16 * n2 + r) * 264 + 32 * w + 16 * m2 + 4 * q) = pk4(S[m2][n2]); } \
        if ((n) + 1 < 128) SB_STORE(0); \
        LBAR(); \
    } while (0)
    for (int n = 0; n < 128; n += 2) { SB_STEP(n, 0); SB_STEP(n + 1, 1); }
#undef SB_STEP
#undef SB_LOAD
#undef SB_STORE
}

#define XB_TMO      128
#define XB_XCNT(j)  (256  + 64 * (j))
#define XB_XSUB(j)  (1280 + 64 * (j))
#define XB_XGEN(j)  (2304 + 64 * (j))
#define XB_TOP      3328
#define XB_TOPGEN   3392
#define XCD_BAR_WORDS 3456
#define XB_SPIN_CAP (1u << 18)

__device__ __forceinline__ unsigned xb_ld(unsigned* p)              { return __hip_atomic_load(p, __ATOMIC_RELAXED, __HIP_MEMORY_SCOPE_AGENT); }
__device__ __forceinline__ unsigned xb_add(unsigned* p, unsigned v) { return __hip_atomic_fetch_add(p, v, __ATOMIC_RELAXED, __HIP_MEMORY_SCOPE_AGENT); }
__device__ __forceinline__ unsigned xb_xcc_id() { return (unsigned)__builtin_amdgcn_s_getreg((3 << 11) | 20) & 0xFu; }
#define XB_SPIN(cond, bar) do { unsigned _sp = 0; while (cond) { __builtin_amdgcn_s_sleep(1); \
    if ((++_sp & 255u) == 0u) { if (xb_ld(&(bar)[XB_TMO])) break; if (_sp > XB_SPIN_CAP) { atomicAdd(&(bar)[XB_TMO], 1u); break; } } } } while (0)

struct XcdBarrier {
    unsigned* bar; unsigned x;
    volatile LAS unsigned* st;
};

__device__ __forceinline__ XcdBarrier xcd_barrier_post(unsigned* bar, volatile LAS unsigned* st) {
    XcdBarrier b; b.bar = bar; b.x = xb_xcc_id(); b.st = st;
    if (threadIdx.x == 0) (void)xb_add(&bar[XB_XCNT(b.x)], 1u);
    return b;
}
__device__ __forceinline__ void xcd_barrier_complete(unsigned* bar, unsigned x, unsigned& nloc, unsigned& nx) {
    const unsigned G = gridDim.x * gridDim.y * gridDim.z;
    unsigned sum, cnt, mine, sp = 0u;
    for (;;) {
        sum = 0u; cnt = 0u; mine = 0u;
#pragma unroll
        for (unsigned j = 0; j < 16; ++j) { const unsigned c = xb_ld(&bar[XB_XCNT(j)]); sum += c; cnt += (c > 0u) ? 1u : 0u; mine = (j == x) ? c : mine; }
        if (sum == G) break;
        __builtin_amdgcn_s_sleep(1);
        if ((++sp & 255u) == 0u) { if (xb_ld(&bar[XB_TMO])) break; if (sp > XB_SPIN_CAP) { atomicAdd(&bar[XB_TMO], 1u); break; } }
    }
    nloc = mine > 0u ? mine : 1u; nx = cnt > 0u ? cnt : 1u;
}

__device__ __forceinline__ void xcd_barrier(const XcdBarrier& b) {
    asm volatile("s_waitcnt vmcnt(0)" ::: "memory");
    __syncthreads();
    int xt_ = threadIdx.x; asm volatile("" : "+v"(xt_));
    if (xt_ == 0) {
        unsigned* bar = b.bar;
        __builtin_amdgcn_s_waitcnt(0);
        unsigned nloc = b.st[0], nx = b.st[1];
        if (nloc == 0u) { xcd_barrier_complete(bar, b.x, nloc, nx); b.st[0] = nloc; b.st[1] = nx; }
        const unsigned old = xb_add(&bar[XB_XSUB(b.x)], 1u);
        const unsigned gen = old / nloc;
        if (old + 1u == (gen + 1u) * nloc) {
            __builtin_amdgcn_fence(__ATOMIC_RELEASE, "agent");
            asm volatile("s_waitcnt vmcnt(0)" ::: "memory");
            const unsigned og = xb_add(&bar[XB_TOP], 1u);
            const unsigned tg = og / nx;
            if (og + 1u == (tg + 1u) * nx) xb_add(&bar[XB_TOPGEN], 1u);
            else XB_SPIN(xb_ld(&bar[XB_TOPGEN]) == tg, bar);
            __builtin_amdgcn_fence(__ATOMIC_ACQUIRE, "agent");
            xb_add(&bar[XB_XGEN(b.x)], 1u);
            asm volatile("s_waitcnt vmcnt(0)" ::: "memory");
        } else {
            XB_SPIN(xb_ld(&bar[XB_XGEN(b.x)]) == gen, bar);
            __builtin_amdgcn_fence(__ATOMIC_ACQUIRE, "agent");
            asm volatile("s_waitcnt vmcnt(0)" ::: "memory");
        }
    }
    __syncthreads();
}


typedef const __attribute__((address_space(4))) Params* kparams_t;
__device__ __forceinline__ Params load_params() {
#if defined(__HIP_DEVICE_COMPILE__)
    kparams_t kp = (kparams_t)__builtin_amdgcn_kernarg_segment_ptr(); asm volatile("" : "+s"(kp)); return *kp;
#else
    return Params{};
#endif
}
__global__ void __launch_bounds__(NTHREADS) hybrid_fwd(Params p_unused) {
    extern __shared__ __attribute__((aligned(16))) unsigned char lds_raw[];
    LAS unsigned char* lds = (LAS unsigned char*)lds_raw;
    cg::grid_group grid = cg::this_grid();
    using pg8::Gemm; using pg8::StaticOrder;
#define PH_BEGIN { const Params p = load_params(); unsigned char* ws = p.ws; int G_ = gridDim.x, bx_ = blockIdx.x; asm volatile("" : "+s"(G_), "+s"(bx_)); const int G = G_, bx = bx_; (void)ws; (void)G; (void)bx;
#define GRID_BAR() do { XcdBarrier xb_; xb_.bar = (unsigned*)load_params().ws; unsigned x_ = xcc_; asm volatile("" : "+s"(x_)); xb_.x = x_; xb_.st = xst; xcd_barrier(xb_); } while (0)
#define PH_END } GRID_BAR();
    volatile LAS unsigned* xst = (volatile LAS unsigned*)(lds + LDS_BYTES - 64);
    if (threadIdx.x < 16) xst[threadIdx.x] = 0u;
    __syncthreads();
    unsigned xcc_;
    { const Params p0 = load_params(); const XcdBarrier xbar = xcd_barrier_post((unsigned*)p0.ws, xst); xcc_ = __builtin_amdgcn_readfirstlane(xbar.x); }

    { const Params p = load_params(); prologue(p, lds); }
    { const Params p = load_params(); if (p.ws == nullptr) grid.sync(); }
    GRID_BAR();

    for (int half = 0; half < 2; ++half) {
        PH_BEGIN
          Gemm g{(const bf16_t*)(ws + WS_XN) + (size_t)half * MH * D, D, (const bf16_t*)(ws + WS_W1A), MH, 8192, D}; StaticOrder S; S.init(MH, 8192, G, bx);
          pg8::Epi<1> E{}; E.out1 = (bf16_t*)(ws + WS_OUT1); E.ropec = (const float*)(ws + WS_ROPEC); E.ropes = (const float*)(ws + WS_ROPES);
          pg8::gemm_phase<pg8::Epi<1>, StaticOrder, true>(lds, g, S, E);
        PH_END
        PH_BEGIN
          for (int it = bx; it < 2048; it += 4 * G) {
#pragma unroll 1
            for (int sl = 0; sl < 4; ++sl) prepA_item(p, lds, half, it + sl * G, sl);
            int tid2_ = threadIdx.x; asm volatile("" : "+v"(tid2_)); const int wv_ = tid2_ >> 6;
            if (wv_ < 4) prepA_invert(p, lds, it + wv_ * G, wv_);
            else { const int b0 = bx + ((it - bx) >> 1); prepB_wave(p, b0, wv_ - 4); prepB_wave(p, b0 + G, wv_ - 4); }
            __syncthreads(); }
        PH_END
        PH_BEGIN
          for (int it = bx; it < 256; it += G) { const int xcd = it & 7, slot = it >> 3;
            if (slot < 16) scanA(p, lds, half, xcd * 2 + (slot >> 3), slot & 7); else scanB(p, lds, xcd, slot - 16);
            __syncthreads(); }
        PH_END
        PH_BEGIN
          Gemm g{(const bf16_t*)(ws + WS_XN) + (size_t)half * MH * D, D, (const bf16_t*)(ws + WS_W1B), MH, 6144, D}; StaticOrder S; S.init(MH, 6144, G, bx);
          pg8::Epi<4> E{}; E.lds_top = lds + pg8::STAGE_BYTES; E.out1 = (bf16_t*)(ws + WS_OUT1); E.gso = (bf16_t*)(ws + WS_QKN); E.ssqa = (const float*)(ws + WS_SSQA); E.ssqb = (const float*)(ws + WS_SSQB); E.norm_a = p.norm_a; E.norm_b = p.norm_b;
          pg8::gemm_phase<pg8::Epi<4>, StaticOrder, true>(lds, g, S, E);
        PH_END
        PH_BEGIN
          Gemm g{(const bf16_t*)(ws + WS_OUT1), LDO, (const bf16_t*)(ws + WS_WBRA), MH, D, 4096, (6144 - 2048) * 2}; StaticOrder S; S.init(MH, D, G, bx);
          pg8::Epi<13> E{}; E.gs = (const bf16_t*)(ws + WS_QKN); E.ob = (bf16_t*)(ws + WS_TA);
          pg8::gemm_phase<pg8::Epi<13>, StaticOrder, true>(lds, g, S, E);
        PH_END
        PH_BEGIN
          Gemm g{(const bf16_t*)(ws + WS_TA), D, (const bf16_t*)(ws + WS_WOUT), MH, D, D}; StaticOrder S; S.init(MH, D, G, bx);
          pg8::Epi<12> E{}; E.of = p.out + (size_t)half * MH * D; E.xin = p.x + (size_t)half * MH * D; E.hn = (bf16_t*)(ws + WS_QKN);     E.nw = p.n_mix_post; E.nw2 = p.n_mlp_pre;
          E.xbuf = (unsigned*)(ws + WS_SSQA + (size_t)(half * 3 + 1) * 262144); E.cnt = (unsigned*)(ws + 16384) + (half * 3 + 1) * 4096;
          E.xbuf2 = (unsigned*)(ws + WS_SSQA + (size_t)(half * 3 + 2) * 262144); E.cnt2 = (unsigned*)(ws + 16384) + (half * 3 + 2) * 4096;
          pg8::gemm_phase<pg8::Epi<12>, StaticOrder, false>(lds, g, S, E);
        PH_END
        PH_BEGIN
          Gemm g{(const bf16_t*)(ws + WS_QKN), D, (const bf16_t*)(ws + WS_WUP), MH, FF, D}; StaticOrder S; S.init(MH, FF, G, bx);
          pg8::Epi<9> E{}; E.ob = (bf16_t*)(ws + WS_OUT1);
          pg8::gemm_phase<pg8::Epi<9>, StaticOrder, true>(lds, g, S, E);
        PH_END
        PH_BEGIN
          Gemm g{(const bf16_t*)(ws + WS_OUT1), FF, (const bf16_t*)(ws + WS_WDN), MH, D, FF}; StaticOrder S; S.init(MH, D, G, bx);
          pg8::Epi<11> E{}; E.of = p.out + (size_t)half * MH * D; E.nw = p.n_mlp_post;
          E.xbuf = (unsigned*)(ws + WS_SSQA + (size_t)(half * 3) * 262144); E.cnt = (unsigned*)(ws + 16384) + (half * 3) * 4096;
          pg8::gemm_phase<pg8::Epi<11>, StaticOrder, false>(lds, g, S, E);
        } if (half == 0) GRID_BAR();
    }
#undef PH_BEGIN
#undef PH_END
}

extern "C" void kernel_launch(void* const* d_in, const int* in_sizes, int n_in, void* d_out, int out_size, void* d_ws, size_t ws_size, hipStream_t stream) {
    static int grid = 0;
    if (grid == 0) {
        if (n_in != 16 || in_sizes[0] != M * D || out_size != M * D || ws_size < WS_END) { fprintf(stderr, "kernel_launch: unexpected shapes / workspace (n_in %d, ws %zu)\n", n_in, ws_size); grid = -1; return; }
        int dev = 0, cus = 0, per_cu = 0;
        hipGetDevice(&dev); hipDeviceGetAttribute(&cus, hipDeviceAttributeMultiprocessorCount, dev);
        if (hipFuncSetAttribute((const void*)hybrid_fwd, hipFuncAttributeMaxDynamicSharedMemorySize, LDS_BYTES) != hipSuccess) { fprintf(stderr, "kernel_launch: hipFuncSetAttribute failed\n"); grid = -1; return; }
        if (hipOccupancyMaxActiveBlocksPerMultiprocessor(&per_cu, (const void*)hybrid_fwd, NTHREADS, LDS_BYTES) != hipSuccess || per_cu < 1) { fprintf(stderr, "kernel_launch: occupancy query failed (%d)\n", per_cu); grid = -1; (void)hipGetLastError(); return; }
        grid = 1; while (grid * 2 <= cus && grid < 512) grid *= 2;
    }
    if (grid < 0) return;
    if (hipMemsetAsync(d_ws, 0, 131072, stream) != hipSuccess) { fprintf(stderr, "kernel_launch: hipMemsetAsync of the barrier words failed\n"); return; }
    Params p{};
    p.x = (const float*)d_in[0]; p.n_mix_pre = (const float*)d_in[1]; p.n_mix_post = (const float*)d_in[2]; p.n_mlp_pre = (const float*)d_in[3]; p.n_mlp_post = (const float*)d_in[4];
    p.w_in = (const float*)d_in[5]; p.conv_a = (const float*)d_in[6]; p.a_log = (const float*)d_in[7]; p.dt_bias = (const float*)d_in[8]; p.norm_a = (const float*)d_in[9]; p.norm_b = (const float*)d_in[10];
    p.w_br_a = (const float*)d_in[11]; p.w_br_b = (const float*)d_in[12]; p.w_out = (const float*)d_in[13]; p.w_up = (const float*)d_in[14]; p.w_down = (const float*)d_in[15];
    p.out = (float*)d_out; p.ws = (unsigned char*)d_ws;
    void* args[] = {&p};
    hipError_t e = hipLaunchCooperativeKernel((const void*)hybrid_fwd, dim3(grid), dim3(NTHREADS), args, LDS_BYTES, stream);
    if (e != hipSuccess) fprintf(stderr, "kernel_launch: cooperative launch failed: %s (grid %d)\n", hipGetErrorString(e), grid);
}

static_assert(WS_OUT1 + (size_t)MH * LDO * 2 <= WS_QKN && WS_END <= 512 * MiB, "d_ws map");
```

```cpp
#include <hip/hip_runtime.h>
#include <hip/hip_cooperative_groups.h>
#include <cstdio>
#include <cstdint>
namespace cg = cooperative_groups;

#define LAS __attribute__((address_space(3)))
typedef unsigned short bf16_t;
typedef short bf16x8 __attribute__((ext_vector_type(8)));
typedef float f32x4 __attribute__((ext_vector_type(4)));
typedef unsigned u32x4 __attribute__((ext_vector_type(4)));
typedef unsigned u32x2 __attribute__((ext_vector_type(2)));

constexpr int D = 1024, SEQ = 8192, NB = 4, M = NB * SEQ, MH = M / 2, DIN = 14352, FF = 4096;
constexpr int NTHREADS = 512, NWAVES = 8;
constexpr float EPS = 1e-6f;
constexpr int LDS_BYTES = 147456;
constexpr int LDO = 8192 + 64;

constexpr size_t MiB = 1u << 20;
constexpr size_t WS_W1A = 1 * MiB, WS_W1B = 17 * MiB, WS_WBRA = 29 * MiB, WS_WBRB = 33 * MiB, WS_WOUT = 37 * MiB, WS_WUP = 39 * MiB, WS_WDN = 47 * MiB;
constexpr size_t WS_ROPEC = 55 * MiB, WS_ROPES = 59 * MiB, WS_BETA = 63 * MiB, WS_GG = 64 * MiB, WS_XN = 65 * MiB, WS_OUT1 = 129 * MiB, WS_QKN = 387 * MiB;
constexpr size_t WS_TA = 451 * MiB, WS_GC = 483 * MiB, WS_SC = 484 * MiB, WS_SSQA = 492 * MiB, WS_SSQB = 500 * MiB, WS_END = 508 * MiB;

struct Params {
    const float* x; const float* n_mix_pre; const float* n_mix_post; const float* n_mlp_pre; const float* n_mlp_post;
    const float* w_in; const float* conv_a; const float* a_log; const float* dt_bias; const float* norm_a; const float* norm_b;
    const float* w_br_a; const float* w_br_b; const float* w_out; const float* w_up; const float* w_down;
    float* out; unsigned char* ws;
};

typedef float f32x2_t __attribute__((ext_vector_type(2))); typedef __bf16 bf16x2_t __attribute__((ext_vector_type(2)));
__device__ __forceinline__ unsigned pk2(float lo, float hi) { f32x2_t v = {lo, hi}; bf16x2_t b = __builtin_convertvector(v, bf16x2_t); return __builtin_bit_cast(unsigned, b); }
__device__ __forceinline__ unsigned f2bf(float f) { return pk2(f, 0.f) & 0xffffu; }
__device__ __forceinline__ float bf2f(unsigned h) { return __builtin_bit_cast(float, h << 16); }
__device__ __forceinline__ float bflo(unsigned w) { return __builtin_bit_cast(float, w << 16); }
__device__ __forceinline__ float bfhi(unsigned w) { return __builtin_bit_cast(float, w & 0xffff0000u); }
__device__ __forceinline__ float wave_sum(float v) {
#pragma unroll
    for (int o = 1; o < 64; o <<= 1) v += __shfl_xor(v, o);
    return v;
}
__device__ __forceinline__ float sigmoidf_(float z) { return __builtin_amdgcn_rcpf(1.f + __expf(-z)); }
__device__ __forceinline__ float siluf_(float z) { return z * __builtin_amdgcn_rcpf(1.f + __expf(-z)); }
template <int CTRL> __device__ __forceinline__ float dpp_f(float v) { return __builtin_bit_cast(float, __builtin_amdgcn_update_dpp(0, __builtin_bit_cast(int, v), CTRL, 0xf, 0xf, false)); }
__device__ __forceinline__ float row16_sum(float v) { v += dpp_f<0x128>(v); v += dpp_f<0x124>(v); v += dpp_f<0x122>(v); v += dpp_f<0x121>(v); return v; }
__device__ __forceinline__ u32x4 pack8(f32x4 a, f32x4 b) { u32x4 w; w.x = pk2(a[0], a[1]); w.y = pk2(a[2], a[3]); w.z = pk2(b[0], b[1]); w.w = pk2(b[2], b[3]); return w; }
__device__ __forceinline__ void unpack8(u32x4 w, f32x4& a, f32x4& b) { a = (f32x4){bflo(w.x), bfhi(w.x), bflo(w.y), bfhi(w.y)}; b = (f32x4){bflo(w.z), bfhi(w.z), bflo(w.w), bfhi(w.w)}; }
#define MFMA16(a, b, c) __builtin_amdgcn_mfma_f32_16x16x32_bf16((a), (b), (c), 0, 0, 0)
typedef short v4i16_t __attribute__((ext_vector_type(4)));
__device__ __forceinline__ v4i16_t lds_tr16(const LAS bf16_t* p) { return __builtin_amdgcn_ds_read_tr16_b64_v4i16((LAS v4i16_t*)p); }
#define LDS_WAIT() asm volatile("s_waitcnt lgkmcnt(0)" ::: "memory")
#define LBAR() do { asm volatile("s_waitcnt lgkmcnt(0)" ::: "memory"); __builtin_amdgcn_s_barrier(); asm volatile("" ::: "memory"); } while (0)

namespace pg8 {
constexpr int BM = 256, BK = 64, HALF = 128, HTB = HALF * BK * 2, STAGE_BYTES = 8 * HTB, NXCD = 8, WGM = 8;
__host__ __device__ __forceinline__ int lds_byte(int r, int c) { const int st = (r >> 4) * 2 + (c >> 5), rr = r & 15, cc = c & 31, ob = rr * 64 + cc * 2; return st * 1024 + (ob ^ (((ob >> 9) & 1) << 5)); }
__host__ __device__ __forceinline__ void stage_rc(int b, int& R, int& C) { const int st = b / 1024, sb = b % 1024, swz = sb ^ (((sb >> 9) & 1) << 5); R = (st >> 1) * 16 + swz / 64; C = (st & 1) * 32 + (swz % 64) / 2; }
__host__ __device__ __forceinline__ int perm32(int rho) { const int n = rho >> 4, i = rho & 15; return 8 * (i >> 2) + 4 * n + (i & 3); }
struct Unit { int pm, pn; };
struct Gemm { const bf16_t* A; int lda; const bf16_t* Bt; int M, N, K; int ajump; };
struct StaticOrder {
    int nM, nN, nwg, G, c;
    __host__ __device__ void init(int M_, int N_, int G_, int c_) { nM = M_ / BM; nN = N_ / BM; nwg = nM * nN; G = G_; c = c_; }
    __host__ __device__ bool next(int i, Unit& u) const {
        const long L = (long)i * G + c; if (L >= nwg) return false;
        int wgid = (int)L; { const int q = nwg / NXCD, r = nwg % NXCD, xcd = wgid % NXCD, off = wgid / NXCD; wgid = (xcd < r ? xcd * (q + 1) : r * (q + 1) + (xcd - r) * q) + off; }
        const int nig = WGM * nN, gid = wgid / nig, fm = gid * WGM, gsz = (nM - fm) < WGM ? (nM - fm) : WGM;
        u.pm = fm + ((wgid % nig) % gsz); u.pn = (wgid % nig) / gsz; return true;
    }
};

template <int MODE> struct Epi {
    static constexpr bool PERM = (MODE != 11 && MODE != 12), AFTER_DRAIN = (MODE == 11 || MODE == 12), MID = (MODE == 13);
    bf16_t* ob; float* of; const bf16_t* gs; bf16_t* gso; bf16_t* out1; LAS unsigned char* lds_top;
    const float *ssqa, *ssqb, *norm_a, *norm_b, *ropec, *ropes;
    const float* nw; unsigned* xbuf; unsigned* cnt; const float* nw2; unsigned* xbuf2; unsigned* cnt2; const float* xin; bf16_t* hn;
    __device__ __forceinline__ void mid(f32x4 (&acc)[2][2][4][2], const Unit& u, int wr, int wc, int fr, int fq) const {
        int zo_ = 0; asm volatile("" : "+v"(zo_));
        const int row0 = u.pm * BM + wr * 64 + fr + zo_, cb = wc * 32 + 8 * fq;
#pragma unroll
        for (int ai = 0; ai < 2; ++ai)
#pragma unroll
            for (int m = 0; m < 4; ++m) { const bf16_t* gp = gs + (size_t)(row0 + ai * HALF + m * 16) * 2048 + u.pn * BM + cb;
#pragma unroll
                for (int bj = 0; bj < 2; ++bj) { f32x4 a0, a1, b0, b1; unpack8(*(const u32x4*)(gp + bj * HALF), a0, a1); unpack8(*(const u32x4*)(gp + 1024 + bj * HALF), b0, b1);
#pragma unroll
                    for (int e = 0; e < 4; ++e) { a0[e] *= __builtin_amdgcn_rcpf(b0[e]); a1[e] *= __builtin_amdgcn_rcpf(b1[e]); }
                    acc[ai][bj][m][0] = acc[ai][bj][m][0] * a0; acc[ai][bj][m][1] = acc[ai][bj][m][1] * a1; }
                asm volatile("" ::: "memory"); }
    }
    __device__ __forceinline__ void row_rstd(const f32x4 (&acc)[2][2][4][2], const Unit& u, int wr, int wc, int fr, int fq, LAS unsigned char* lds, int wid, int lane, unsigned* xb, unsigned* ct) const {
        LAS float* P = (LAS float*)lds;
        LAS float* SR = (LAS float*)(lds + 8192);
#pragma unroll
        for (int ai = 0; ai < 2; ++ai)
#pragma unroll
            for (int m = 0; m < 4; ++m) { float sq = 0.f;
#pragma unroll
                for (int bj = 0; bj < 2; ++bj)
#pragma unroll
                    for (int n = 0; n < 2; ++n) { const f32x4 x = acc[ai][bj][m][n]; sq += (x[0] * x[0] + x[1] * x[1]) + (x[2] * x[2] + x[3] * x[3]); }
                sq += __shfl_xor(sq, 16); sq += __shfl_xor(sq, 32);
                if (fq == 0) P[(ai * HALF + wr * 64 + m * 16 + fr) * 4 + wc] = sq; }
        asm volatile("s_waitcnt lgkmcnt(0)" ::: "memory"); __builtin_amdgcn_s_barrier(); asm volatile("" ::: "memory");
        const int row = wid * 32 + (lane & 31);
        if (lane < 32) { const float tot = (P[row * 4 + 0] + P[row * 4 + 1]) + (P[row * 4 + 2] + P[row * 4 + 3]);
            __hip_atomic_store(xb + ((size_t)(u.pm * BM + row) * 4 + u.pn), __builtin_bit_cast(unsigned, tot), __ATOMIC_RELAXED, __HIP_MEMORY_SCOPE_AGENT); }
        asm volatile("s_waitcnt vmcnt(0)" ::: "memory");
        if (lane == 0) __hip_atomic_fetch_add(ct + 64 * u.pm, 1u, __ATOMIC_RELAXED, __HIP_MEMORY_SCOPE_AGENT);
        if (wid == 0) { unsigned sp_ = 0;
            while ((unsigned)__builtin_amdgcn_readfirstlane(__hip_atomic_load(ct + 64 * u.pm, __ATOMIC_RELAXED, __HIP_MEMORY_SCOPE_AGENT)) < 32u) { __builtin_amdgcn_s_sleep(2); if (++sp_ > (1u << 22)) break; }
            __builtin_amdgcn_fence(__ATOMIC_ACQUIRE, "agent"); }
        asm volatile("s_waitcnt vmcnt(0) lgkmcnt(0)" ::: "memory"); __builtin_amdgcn_s_barrier(); asm volatile("" ::: "memory");
        if (lane < 32) { const unsigned* sl = xb + (size_t)(u.pm * BM + row) * 4; float tot = 0.f;
#pragma unroll
            for (int t = 0; t < 4; ++t) tot += __builtin_bit_cast(float, __hip_atomic_load(sl + t, __ATOMIC_RELAXED, __HIP_MEMORY_SCOPE_AGENT));
            SR[row] = rsqrtf(tot * (1.f / 1024.f) + EPS); }
        asm volatile("s_waitcnt lgkmcnt(0)" ::: "memory"); __builtin_amdgcn_s_barrier(); asm volatile("" ::: "memory");
    }
    __device__ __forceinline__ void fused(f32x4 (&acc)[2][2][4][2], const Unit& u, int wr, int wc, int fr, int fq, LAS unsigned char* lds, int wid, int lane) const {
        const LAS float* SR = (const LAS float*)(lds + 8192);
        const int col0 = u.pn * BM + wc * 32 + 4 * fq;
        if constexpr (MODE == 11) {
            f32x4 pre[4][2][2];
#pragma unroll
            for (int m = 0; m < 4; ++m) { const size_t off = (size_t)(u.pm * BM + wr * 64 + m * 16 + fr) * 1024 + col0;
#pragma unroll
                for (int bj = 0; bj < 2; ++bj)
#pragma unroll
                    for (int n = 0; n < 2; ++n) pre[m][bj][n] = *(const f32x4*)(of + off + bj * HALF + n * 16); }
            row_rstd(acc, u, wr, wc, fr, fq, lds, wid, lane, xbuf, cnt);
#pragma unroll
            for (int ai = 0; ai < 2; ++ai)
#pragma unroll
                for (int m = 0; m < 4; ++m) { const int rl = ai * HALF + wr * 64 + m * 16 + fr; const float rstd = SR[rl]; const size_t off = (size_t)(u.pm * BM + rl) * 1024 + col0;
#pragma unroll
                    for (int bj = 0; bj < 2; ++bj)
#pragma unroll
                        for (int n = 0; n < 2; ++n) { const int cc = bj * HALF + n * 16; const f32x4 w = *(const f32x4*)(nw + col0 + cc);
                            float* o = of + off + cc; const f32x4 bs = ai == 0 ? pre[m][bj][n] : *(const f32x4*)o; *(f32x4*)o = bs + acc[ai][bj][m][n] * rstd * w; }
                    asm volatile("" ::: "memory"); }
        } else {
            f32x4 pre[4][2][2];
#pragma unroll
            for (int m = 0; m < 4; ++m) { const size_t off = (size_t)(u.pm * BM + wr * 64 + m * 16 + fr) * 1024 + col0;
#pragma unroll
                for (int bj = 0; bj < 2; ++bj)
#pragma unroll
                    for (int n = 0; n < 2; ++n) pre[m][bj][n] = *(const f32x4*)(xin + off + bj * HALF + n * 16); }
            row_rstd(acc, u, wr, wc, fr, fq, lds, wid, lane, xbuf, cnt);
#pragma unroll
            for (int ai = 0; ai < 2; ++ai)
#pragma unroll
                for (int m = 0; m < 4; ++m) { const int rl = ai * HALF + wr * 64 + m * 16 + fr; const float rstd = SR[rl]; const size_t off = (size_t)(u.pm * BM + rl) * 1024 + col0;
#pragma unroll
                    for (int bj = 0; bj < 2; ++bj)
#pragma unroll
                        for (int n = 0; n < 2; ++n) { const int cc = bj * HALF + n * 16; const f32x4 w = *(const f32x4*)(nw + col0 + cc);
                            const f32x4 bs = ai == 0 ? pre[m][bj][n] : *(const f32x4*)(xin + off + cc); acc[ai][bj][m][n] = bs + acc[ai][bj][m][n] * rstd * w; }
                    asm volatile("" : "+v"(acc[ai][0][m][0]), "+v"(acc[ai][0][m][1]), "+v"(acc[ai][1][m][0]), "+v"(acc[ai][1][m][1]));
                    asm volatile("" ::: "memory"); }
            row_rstd(acc, u, wr, wc, fr, fq, lds, wid, lane, xbuf2, cnt2);
#pragma unroll
            for (int ai = 0; ai < 2; ++ai)
#pragma unroll
                for (int m = 0; m < 4; ++m) { const int rl = ai * HALF + wr * 64 + m * 16 + fr; const float rstd = SR[rl]; const size_t off = (size_t)(u.pm * BM + rl) * 1024 + col0;
#pragma unroll
                    for (int bj = 0; bj < 2; ++bj)
#pragma unroll
                        for (int n = 0; n < 2; ++n) { const int cc = bj * HALF + n * 16; const f32x4 w = *(const f32x4*)(nw2 + col0 + cc); const f32x4 x1 = acc[ai][bj][m][n];
                            *(f32x4*)(of + off + cc) = x1; const f32x4 t = x1 * rstd * w; u32x2 pkd; pkd.x = pk2(t[0], t[1]); pkd.y = pk2(t[2], t[3]); *(u32x2*)(hn + off + cc) = pkd; }
                    asm volatile("" ::: "memory"); }
        }
    }
    template <bool IS_A> __device__ __forceinline__ void gate_tile(const f32x4 (&acc)[2][2][4][2], int row0, int cb, int pn, int head, int colbase, const float* nw, int pm, int wr, int wc, int fr, int fq) const {
        LAS float* RS = (LAS float*)(lds_top);
        { const int t_ = (wr * 4 + wc) * 64 + fq * 16 + fr;
          if (t_ < 256) { const int row = pm * BM + t_; float s_ = 0.f;
            if (IS_A) { const f32x4* sp = (const f32x4*)(ssqa + ((size_t)row * 8 + head) * 16);
#pragma unroll
                for (int j = 0; j < 4; ++j) { const f32x4 v = sp[j]; s_ += (v[0] + v[1]) + (v[2] + v[3]); } s_ = s_ * (1.f / 256.f); }
            else { const f32x4* sp = (const f32x4*)(ssqb + ((size_t)row * 4 + head) * 32);
#pragma unroll
                for (int j = 0; j < 8; ++j) { const f32x4 v = sp[j]; s_ += (v[0] + v[1]) + (v[2] + v[3]); } s_ = s_ * (1.f / 512.f); }
            RS[t_] = rsqrtf(s_ + EPS); }
          else RS[t_] = nw[t_ - 256 - cb];
          asm volatile("s_waitcnt lgkmcnt(0)" ::: "memory"); __builtin_amdgcn_s_barrier(); asm volatile("" ::: "memory"); }
#pragma unroll
        for (int ai = 0; ai < 2; ++ai)
#pragma unroll
            for (int m = 0; m < 4; ++m) { const int row = row0 + ai * HALF + m * 16;
                const float rstd = RS[ai * HALF + wr * 64 + m * 16 + fr];
#pragma unroll
                for (int bj = 0; bj < 2; ++bj) { bf16_t* pp = out1 + (size_t)row * LDO + colbase + bj * HALF; f32x4 xa, xb; unpack8(*(const u32x4*)pp, xa, xb);
                    const f32x4 w0 = *(const LAS f32x4*)(RS + 256 + bj * HALF + cb), w1 = *(const LAS f32x4*)(RS + 256 + bj * HALF + cb + 4);
                    const f32x4 za = acc[ai][bj][m][0], zb = acc[ai][bj][m][1]; f32x4 ga, gb;
#pragma unroll
                    for (int e = 0; e < 4; ++e) { ga[e] = siluf_(za[e]); gb[e] = siluf_(zb[e]); }
                    *(u32x4*)pp = pack8(xa * rstd * w0 * ga, xb * rstd * w1 * gb); }
                asm volatile("" ::: "memory"); }
    }
    __device__ __forceinline__ void operator()(const f32x4 (&acc)[2][2][4][2], const Unit& u, int wr, int wc, int fr, int fq) const {
        const int row0 = u.pm * BM + wr * 64 + fr, cb = wc * 32 + 8 * fq, pn = u.pn;
        if constexpr (MODE == 1) {
            if (pn < 16 || pn >= 24) {
#pragma unroll
                for (int ai = 0; ai < 2; ++ai)
#pragma unroll
                    for (int m = 0; m < 4; ++m) { const size_t ro = (size_t)(row0 + ai * HALF + m * 16) * LDO + pn * BM + cb;
#pragma unroll
                        for (int bj = 0; bj < 2; ++bj) *(u32x4*)(out1 + ro + bj * HALF) = pack8(acc[ai][bj][m][0], acc[ai][bj][m][1]); }
            } else {
                const float sc = pn >= 20 ? 0.0625f : 1.f;
                int zo_ = 0; asm volatile("" : "+v"(zo_));
                float cf[8];
#pragma unroll
                for (int j = 0; j < 8; ++j) cf[j] = exp2f(-(float)(cb + j + zo_) * (13.287712379549449f / 128.f)) * 0.15915494309189535f;
#pragma unroll
                for (int ai = 0; ai < 2; ++ai)
#pragma unroll
                    for (int m = 0; m < 4; ++m) { const int row = row0 + ai * HALF + m * 16; const size_t ro = (size_t)row * LDO + pn * BM + cb; const float pos = (float)(row & (SEQ - 1));
                        f32x4 c0, c1, s0, s1;
#pragma unroll
                        for (int j = 0; j < 4; ++j) { const float r0_ = __builtin_amdgcn_fractf(pos * cf[j]), r1_ = __builtin_amdgcn_fractf(pos * cf[4 + j]);
                            c0[j] = __builtin_amdgcn_cosf(r0_) * sc; s0[j] = __builtin_amdgcn_sinf(r0_) * sc; c1[j] = __builtin_amdgcn_cosf(r1_) * sc; s1[j] = __builtin_amdgcn_sinf(r1_) * sc; }
                        const f32x4 t1a = acc[ai][0][m][0], t1b = acc[ai][0][m][1], t2a = acc[ai][1][m][0], t2b = acc[ai][1][m][1];
                        *(u32x4*)(out1 + ro) = pack8(t1a * c0 - t2a * s0, t1b * c1 - t2b * s1);
                        *(u32x4*)(out1 + ro + HALF) = pack8(t1a * s0 + t2a * c0, t1b * s1 + t2b * c1); }
            }
        } else if constexpr (MODE == 4) {
            if (pn < 8) gate_tile<true>(acc, row0, cb, pn, pn, pn * BM + cb, norm_a + cb, u.pm, wr, wc, fr, fq);
            else if (pn < 16) gate_tile<false>(acc, row0, cb, pn, (pn - 8) >> 1, 6144 + (pn - 8) * BM + cb, norm_b + (pn - 8) * BM + cb, u.pm, wr, wc, fr, fq);
            else {
#pragma unroll
                for (int ai = 0; ai < 2; ++ai)
#pragma unroll
                    for (int m = 0; m < 4; ++m) { const size_t ro = (size_t)(row0 + ai * HALF + m * 16) * 2048 + (pn - 16) * BM + cb;
#pragma unroll
                        for (int bj = 0; bj < 2; ++bj) { const f32x4 za = acc[ai][bj][m][0], zb = acc[ai][bj][m][1]; f32x4 ga, gb;
#pragma unroll
                            for (int e = 0; e < 4; ++e) { ga[e] = sigmoidf_(za[e]); gb[e] = sigmoidf_(zb[e]); }
                            *(u32x4*)(gso + ro + bj * HALF) = pack8(ga, gb); } }
            }
        } else {
#pragma unroll
            for (int ai = 0; ai < 2; ++ai)
#pragma unroll
                for (int m = 0; m < 4; ++m) { const int row = row0 + ai * HALF + m * 16;
#pragma unroll
                    for (int bj = 0; bj < 2; ++bj) { const int col = pn * BM + bj * HALF + cb; const f32x4 va = acc[ai][bj][m][0], vb = acc[ai][bj][m][1];
                        if constexpr (MODE == 5) { f32x4 ga, gb; unpack8(*(const u32x4*)(gs + (size_t)row * 2048 + col), ga, gb);
                            float* o = of + (size_t)row * 1024 + col; *(f32x4*)o = va * ga; *(f32x4*)(o + 4) = vb * gb; }
                        else if constexpr (MODE == 6) { f32x4 ga, gb; unpack8(*(const u32x4*)(gs + (size_t)row * 2048 + 1024 + col), ga, gb);
                            const float* o = of + (size_t)row * 1024 + col; const f32x4 ta = *(const f32x4*)o, tb = *(const f32x4*)(o + 4);
                            *(u32x4*)(ob + (size_t)row * 1024 + col) = pack8(ta + va * ga, tb + vb * gb); }
                        else if constexpr (MODE == 7) { float* o = of + (size_t)row * 1024 + col; *(f32x4*)o = va; *(f32x4*)(o + 4) = vb; }
                        else if constexpr (MODE == 13) { f32x4 ga, gb; unpack8(*(const u32x4*)(gs + (size_t)row * 2048 + 1024 + col), ga, gb); *(u32x4*)(ob + (size_t)row * 1024 + col) = pack8(va * ga, vb * gb); }
                        else if constexpr (MODE == 9) { f32x4 ra, rb;
#pragma unroll
                            for (int e = 0; e < 4; ++e) { const float a = fmaxf(va[e], 0.f), b = fmaxf(vb[e], 0.f); ra[e] = a * a; rb[e] = b * b; }
                            *(u32x4*)(ob + (size_t)row * 4096 + col) = pack8(ra, rb); }
                    } }
        }
    }
};

template <class EpiT, class Sched, bool ALIGN_EPI>
__device__ __forceinline__ void gemm_phase(LAS unsigned char* lds, const Gemm g, const Sched& S, const EpiT& E) {
    int tid_ = threadIdx.x; asm volatile("" : "+v"(tid_));
    const int tid = tid_, wid = __builtin_amdgcn_readfirstlane(tid >> 6), lane = tid & 63, wr = wid >> 2, wc = wid & 3, fr = lane & 15, fq = lane >> 4;
    const int K = g.K, nt = K / BK, lda = g.lda;
    unsigned voffA[2], voffB[2];
#pragma unroll
    for (int i = 0; i < 2; ++i) { int R, C; stage_rc(tid * 16 + i * 8192, R, C); const int Rb = EpiT::PERM ? ((R & ~31) + perm32(R & 31)) : R;
        voffA[i] = (unsigned)(R * lda + C) * 2u; voffB[i] = (unsigned)(Rb * K + C) * 2u; }
    const size_t kstep = (size_t)(BK * 2);
    const size_t hstepA = (size_t)HALF * lda * 2, hstepB = (size_t)HALF * K * 2;
    const size_t tstepA = 2 * hstepA, tstepB = 2 * hstepB;
    const unsigned ldsw = (unsigned)wid * 1024u;
    const int aoff = lds_byte(wr * 64 + fr, fq * 8), boff = lds_byte(wc * 32 + fr, fq * 8);
#define PG8_SA(b, h) (((b) * 2 + (h)) * HTB)
#define PG8_SB(b, h) ((4 + (b) * 2 + (h)) * HTB)
#define PG8_STAGE(bufoff, gbase, voff) do { _Pragma("unroll") for (int _i = 0; _i < 2; ++_i) \
        __builtin_amdgcn_global_load_lds((const unsigned*)((const char*)(gbase) + (voff)[_i]), (LAS unsigned*)(lds + (bufoff) + ldsw + _i * 8192), 16, 0, 0); } while (0)
#define PG8_LDA(dst, b, h) do { _Pragma("unroll") for (int m = 0; m < 4; ++m) _Pragma("unroll") for (int k = 0; k < 2; ++k) dst[m][k] = *(const LAS bf16x8*)(lds + PG8_SA(b, h) + aoff + m * 2048 + k * 1024); } while (0)
#define PG8_LDB(dst, b, h) do { _Pragma("unroll") for (int n = 0; n < 2; ++n) _Pragma("unroll") for (int k = 0; k < 2; ++k) dst[n][k] = *(const LAS bf16x8*)(lds + PG8_SB(b, h) + boff + n * 2048 + k * 1024); } while (0)
#define PG8_MMA(ai, bj, At, Bt) do { __builtin_amdgcn_s_setprio(1); _Pragma("unroll") for (int m = 0; m < 4; ++m) _Pragma("unroll") for (int n = 0; n < 2; ++n) _Pragma("unroll") for (int k = 0; k < 2; ++k) \
        acc[ai][bj][m][n] = __builtin_amdgcn_mfma_f32_16x16x32_bf16(Bt[n][k], At[m][k], acc[ai][bj][m][n], 0, 0, 0); __builtin_amdgcn_s_setprio(0); } while (0)
#define PG8_WAIT_V(n) asm volatile("s_waitcnt vmcnt(" #n ")" ::: "memory")
#define PG8_WAIT_L(n) asm volatile("s_waitcnt lgkmcnt(" #n ")" ::: "memory")
#define PG8_BAR __builtin_amdgcn_s_barrier()
#define PG8_SCHED __builtin_amdgcn_sched_barrier(0)
    Unit cur, nxt; int ui = 0;
    if (!S.next(0, cur)) return;
    f32x4 acc[2][2][4][2];
#pragma unroll
    for (int a = 0; a < 2; ++a)
#pragma unroll
        for (int b = 0; b < 2; ++b)
#pragma unroll
            for (int m = 0; m < 4; ++m)
#pragma unroll
                for (int n = 0; n < 2; ++n) acc[a][b][m][n] = (f32x4){0.f, 0.f, 0.f, 0.f};
    bf16x8 At[4][2], B0[2][2], B1[2][2];
    const char* cA = (const char*)g.A + (size_t)cur.pm * tstepA; const char* cB = (const char*)g.Bt + (size_t)cur.pn * tstepB;
    PG8_STAGE(PG8_SB(0, 0), cB, voffB); PG8_STAGE(PG8_SB(0, 1), cB + hstepB, voffB); PG8_STAGE(PG8_SA(0, 0), cA, voffA); PG8_STAGE(PG8_SA(0, 1), cA + hstepA, voffA);
    if (wr == 1) PG8_BAR;
    PG8_WAIT_V(2); PG8_BAR;
    PG8_STAGE(PG8_SB(1, 0), cB + kstep, voffB); PG8_STAGE(PG8_SA(1, 0), cA + kstep, voffA); PG8_STAGE(PG8_SB(1, 1), cB + hstepB + kstep, voffB);
    PG8_WAIT_V(6); PG8_BAR;
    for (;;) {
        const bool has_next = S.next(ui + 1, nxt);
        const char* nA = has_next ? (const char*)g.A + (size_t)nxt.pm * tstepA : cA; const char* nB = has_next ? (const char*)g.Bt + (size_t)nxt.pn * tstepB : cB;
        for (int t = 0; t < nt; t += 2) {
            const bool last = (t == nt - 2);
            const size_t aj1 = (EpiT::MID && t + 1 >= nt / 2) ? (size_t)g.ajump : 0, aj2 = (EpiT::MID && t + 2 >= nt / 2) ? (size_t)g.ajump : 0;
            if constexpr (EpiT::MID) { PG8_SCHED; if (t == nt / 2) E.mid(acc, cur, wr, wc, fr, fq); PG8_SCHED; }
            const char* a1 = cA + (size_t)(t + 1) * kstep + aj1;
            const char* a2 = last ? nA : cA + (size_t)(t + 2) * kstep + aj2; const char* b2 = last ? nB : cB + (size_t)(t + 2) * kstep;
            const char* a3 = a2 + kstep; const char* b3 = b2 + kstep;
            PG8_LDB(B0, 0, 0); PG8_LDB(B1, 0, 1); PG8_SCHED; PG8_LDA(At, 0, 0); PG8_STAGE(PG8_SA(1, 1), a1 + hstepA, voffA);
            PG8_WAIT_V(8); PG8_WAIT_L(0); PG8_BAR; PG8_MMA(0, 0, At, B0); PG8_MMA(0, 1, At, B1); PG8_BAR; PG8_SCHED;
            PG8_LDA(At, 0, 1); PG8_STAGE(PG8_SB(0, 0), b2, voffB); PG8_STAGE(PG8_SB(0, 1), b2 + hstepB, voffB); PG8_STAGE(PG8_SA(0, 0), a2, voffA);
            PG8_WAIT_V(8); PG8_WAIT_L(0); PG8_BAR; PG8_MMA(1, 0, At, B0); PG8_MMA(1, 1, At, B1); PG8_BAR; PG8_SCHED;
            PG8_LDB(B0, 1, 0); PG8_LDB(B1, 1, 1); PG8_SCHED; PG8_LDA(At, 1, 0); PG8_STAGE(PG8_SA(0, 1), a2 + hstepA, voffA);
            PG8_WAIT_V(8); PG8_WAIT_L(0); PG8_BAR; PG8_MMA(0, 0, At, B0); PG8_MMA(0, 1, At, B1); PG8_BAR; PG8_SCHED;
            PG8_LDA(At, 1, 1); PG8_STAGE(PG8_SB(1, 0), b3, voffB); PG8_STAGE(PG8_SB(1, 1), b3 + hstepB, voffB); PG8_STAGE(PG8_SA(1, 0), a3, voffA);
            PG8_WAIT_V(8); PG8_WAIT_L(0); PG8_BAR; PG8_MMA(1, 0, At, B0); PG8_MMA(1, 1, At, B1); PG8_BAR; PG8_SCHED;
        }
        if constexpr (ALIGN_EPI) { if (wr == 0) PG8_BAR; }
        if constexpr (!EpiT::AFTER_DRAIN) E(acc, cur, wr, wc, fr, fq);
        if (!has_next) break;
#pragma unroll
        for (int a = 0; a < 2; ++a)
#pragma unroll
            for (int b = 0; b < 2; ++b)
#pragma unroll
                for (int m = 0; m < 4; ++m)
#pragma unroll
                    for (int n = 0; n < 2; ++n) acc[a][b][m][n] = (f32x4){0.f, 0.f, 0.f, 0.f};
        cur = nxt; cA = nA; cB = nB; ++ui;
        if constexpr (ALIGN_EPI) { if (wr == 1) PG8_BAR; }
    }
    PG8_WAIT_V(0);
    if constexpr (!ALIGN_EPI) { if (wr == 0) PG8_BAR; }
    PG8_BAR;
    if constexpr (EpiT::AFTER_DRAIN) E.fused(acc, cur, wr, wc, fr, fq, lds, wid, lane);
#undef PG8_SA
#undef PG8_SB
#undef PG8_STAGE
#undef PG8_LDA
#undef PG8_LDB
#undef PG8_MMA
#undef PG8_WAIT_V
#undef PG8_WAIT_L
#undef PG8_BAR
#undef PG8_SCHED
}
}

__device__ __forceinline__ void transpose_item(const float* W, int ldw, int K, int ncols, bf16_t* WT, int row_off, LAS float* scr, int item, int lane, int ldt = 0, int koff = 0) {
    if (ldt == 0) ldt = K;
    const int nblk = ncols / 32, kb = item / nblk, nb = item % nblk, k0 = 64 * kb, n0 = 32 * nb;
#pragma unroll 8
    for (int i = 0; i < 32; ++i) { const int kk = 2 * i + (lane >> 5); scr[kk * 33 + (lane & 31)] = __builtin_nontemporal_load(W + (size_t)(k0 + kk) * ldw + n0 + (lane & 31)); }
    LDS_WAIT(); asm volatile("" ::: "memory");
    const int c = lane & 7;
#pragma unroll
    for (int j = 0; j < 4; ++j) { const int n = (lane >> 3) + 8 * j; const LAS float* s = scr + (8 * c) * 33 + n;
        u32x4 o; o.x = pk2(s[0 * 33], s[1 * 33]); o.y = pk2(s[2 * 33], s[3 * 33]); o.z = pk2(s[4 * 33], s[5 * 33]); o.w = pk2(s[6 * 33], s[7 * 33]);
        *(u32x4*)(WT + (size_t)(row_off + n0 + n) * ldt + koff + k0 + 8 * c) = o; }
    LDS_WAIT(); asm volatile("" ::: "memory");
}

__device__ __forceinline__ void prologue(const Params& p, LAS unsigned char* lds) {
    int tid_ = threadIdx.x; asm volatile("" : "+v"(tid_)); const int tid = tid_, lane = tid & 63, wave = tid >> 6;
    const int gw = blockIdx.x * NWAVES + wave, NGW = gridDim.x * NWAVES;
    unsigned char* ws = p.ws;
    LAS float* scr = (LAS float*)(lds + wave * 9216);
    LAS float* WBT = (LAS float*)(lds + 81856);
    for (int i = tid; i < 1024 * 16; i += NTHREADS) WBT[(i & 15) * 1024 + (i >> 4)] = p.w_in[(size_t)(i >> 4) * DIN + 6144 + (i & 15)];
    constexpr int I1 = 16 * 128, I3 = 16 * 64, I6 = 32 * 32, I8 = 16 * 32, I9 = 16 * 128, I10 = 64 * 32;
    constexpr int NITEMS = 2 * I1 + 3 * I3 + 2 * I6 + I8 + I9 + I10;
    for (int it = gw; it < NITEMS; it += NGW) {
        int r = it;
        if (r < I1) { transpose_item(p.w_in, DIN, 1024, 4096, (bf16_t*)(ws + WS_W1A), 0, scr, r, lane); continue; } r -= I1;
        if (r < I1) { transpose_item(p.w_in + 6160, DIN, 1024, 4096, (bf16_t*)(ws + WS_W1A), 4096, scr, r, lane); continue; } r -= I1;
        if (r < I3) { transpose_item(p.w_in + 4096, DIN, 1024, 2048, (bf16_t*)(ws + WS_W1B), 0, scr, r, lane); continue; } r -= I3;
        if (r < I3) { transpose_item(p.w_in + 10256, DIN, 1024, 2048, (bf16_t*)(ws + WS_W1B), 2048, scr, r, lane); continue; } r -= I3;
        if (r < I3) { transpose_item(p.w_in + 12304, DIN, 1024, 2048, (bf16_t*)(ws + WS_W1B), 4096, scr, r, lane); continue; } r -= I3;
        if (r < I6) { transpose_item(p.w_br_a, 1024, 2048, 1024, (bf16_t*)(ws + WS_WBRA), 0, scr, r, lane, 4096, 0); continue; } r -= I6;
        if (r < I6) { transpose_item(p.w_br_b, 1024, 2048, 1024, (bf16_t*)(ws + WS_WBRA), 0, scr, r, lane, 4096, 2048); continue; } r -= I6;
        if (r < I8) { transpose_item(p.w_out, 1024, 1024, 1024, (bf16_t*)(ws + WS_WOUT), 0, scr, r, lane); continue; } r -= I8;
        if (r < I9) { transpose_item(p.w_up, 4096, 1024, 4096, (bf16_t*)(ws + WS_WUP), 0, scr, r, lane); continue; } r -= I9;
        transpose_item(p.w_down, 1024, 4096, 1024, (bf16_t*)(ws + WS_WDN), 0, scr, r, lane);
    }
    __syncthreads();
    {
        bf16_t* XN = (bf16_t*)(ws + WS_XN); float* BETA = (float*)(ws + WS_BETA); float* GG = (float*)(ws + WS_GG);
        f32x4 nw[4];
#pragma unroll
        for (int j = 0; j < 4; ++j) nw[j] = *((const f32x4*)p.n_mix_pre + lane + 64 * j);
        const float alog = p.a_log[lane & 7], dtb = p.dt_bias[lane & 7];
        for (int m = gw; m < M; m += NGW) {
            const f32x4* xr = (const f32x4*)(p.x + (size_t)m * D) + lane;
            f32x4 v[4]; float s = 0.f;
#pragma unroll
            for (int j = 0; j < 4; ++j) { v[j] = __builtin_nontemporal_load(xr + 64 * j); s += (v[j][0] * v[j][0] + v[j][1] * v[j][1]) + (v[j][2] * v[j][2] + v[j][3] * v[j][3]); }
            const float rstd = rsqrtf(wave_sum(s) * (1.f / D) + EPS);
            unsigned long long* o8 = (unsigned long long*)(XN + (size_t)m * D) + lane;
            float ac[16];
#pragma unroll
            for (int c = 0; c < 16; ++c) ac[c] = 0.f;
#pragma unroll
            for (int j = 0; j < 4; ++j) { v[j] = v[j] * rstd * nw[j];
                o8[64 * j] = (unsigned long long)pk2(v[j][0], v[j][1]) | ((unsigned long long)pk2(v[j][2], v[j][3]) << 32);
#pragma unroll
                for (int c = 0; c < 16; ++c) { const f32x4 w = *(const LAS f32x4*)(WBT + c * 1024 + 256 * j + 4 * lane); ac[c] += (v[j][0] * w[0] + v[j][1] * w[1]) + (v[j][2] * w[2] + v[j][3] * w[3]); }
                asm volatile("" ::: "memory"); }
            float mine = 0.f;
#pragma unroll
            for (int c = 0; c < 16; ++c) { const float t = row16_sum(ac[c]); mine = ((lane & 15) == c) ? t : mine; }
            mine += __shfl_xor(mine, 16); mine += __shfl_xor(mine, 32);
            if (lane < 8) BETA[(size_t)m * 8 + lane] = sigmoidf_(mine);
            else if (lane < 16) { const float z = mine + dtb; const float sp = fmaxf(z, 0.f) + log1pf(__expf(-fabsf(z))); GG[(size_t)m * 8 + (lane - 8)] = -__expf(alog) * sp; }
        }
    }
}

__device__ __forceinline__ void prepA_item(const Params& p, LAS unsigned char* lds, int half, int item, int slot) {
    int tid_ = threadIdx.x; asm volatile("" : "+v"(tid_)); const int tid = tid_, lane = tid & 63, w = tid >> 6, r = lane & 15, q = lane >> 4;
    const int bh = item >> 7, n = item & 127, bl = bh >> 3, h = bh & 7;
    const int rowh = bl * SEQ + n * 64;
    const size_t growb = (size_t)half * MH + rowh;
    unsigned char* ws = p.ws;
    const bf16_t* out1 = (const bf16_t*)(ws + WS_OUT1);
    bf16_t* QKN = (bf16_t*)(ws + WS_QKN); bf16_t* TA = (bf16_t*)(ws + WS_TA) + (size_t)item * 8192; float* GC = (float*)(ws + WS_GC);
    LAS bf16_t* QN = (LAS bf16_t*)lds;
    LAS bf16_t* KN = (LAS bf16_t*)(lds + 17408);
    LAS float* LM = (LAS float*)(lds + 34816 + slot * 17152);
    LAS float* GCS = LM + 64 * 65;
    LAS float* BTS = GCS + 64;
    {
        const int piece = tid & 31, rg = tid >> 5, mat = piece >> 4, col0 = 8 * (piece & 15);
        const int ch = mat * 1024 + h * 128 + col0;
        f32x4 wa[4], wb[4];
#pragma unroll
        for (int j = 0; j < 4; ++j) { wa[j] = *(const f32x4*)(p.conv_a + j * 4096 + ch); wb[j] = *(const f32x4*)(p.conv_a + j * 4096 + ch + 4); }
        const bf16_t* src = out1 + (size_t)rowh * LDO + ch;
        u32x4 xr[7];
#pragma unroll
        for (int j = 0; j < 7; ++j) { const int rr = rg * 4 - 3 + j; xr[j] = __builtin_nontemporal_load((const u32x4*)(src + (ptrdiff_t)((n * 64 + rr < 0) ? 0 : rr) * LDO)); }
        f32x4 xa[7], xb[7];
#pragma unroll
        for (int j = 0; j < 7; ++j) { unpack8(xr[j], xa[j], xb[j]); if (n * 64 + rg * 4 - 3 + j < 0) { xa[j] = (f32x4){0.f, 0.f, 0.f, 0.f}; xb[j] = (f32x4){0.f, 0.f, 0.f, 0.f}; } }
#pragma unroll
        for (int i = 0; i < 4; ++i) { f32x4 ya = wa[0] * xa[i] + wa[1] * xa[i + 1] + wa[2] * xa[i + 2] + wa[3] * xa[i + 3], yb = wb[0] * xb[i] + wb[1] * xb[i + 1] + wb[2] * xb[i + 2] + wb[3] * xb[i + 3];
#pragma unroll
            for (int e = 0; e < 4; ++e) { ya[e] = siluf_(ya[e]); yb[e] = siluf_(yb[e]); }
            const float ss = row16_sum((ya[0] * ya[0] + ya[1] * ya[1]) + (ya[2] * ya[2] + ya[3] * ya[3]) + (yb[0] * yb[0] + yb[1] * yb[1]) + (yb[2] * yb[2] + yb[3] * yb[3]));
            const float inv = rsqrtf(ss + EPS) * (mat == 0 ? 0.08838834764831845f : 1.f);
            const u32x4 o = pack8(ya * inv, yb * inv); const int c = rg * 4 + i;
            *(LAS u32x4*)((mat == 0 ? QN : KN) + c * 136 + col0) = o;
            *(u32x4*)(QKN + (size_t)(rowh + c) * 2048 + mat * 1024 + h * 128 + col0) = o;
            asm volatile("" ::: "memory"); }
    }
    if (w == 0) {
        float g = ((const float*)(ws + WS_GG))[(growb + lane) * 8 + h];
#pragma unroll
        for (int o = 1; o < 64; o <<= 1) { const float t = __shfl_up(g, o); if (lane >= o) g += t; }
        GCS[lane] = g; GC[((size_t)rowh + lane) * 8 + h] = g;
        BTS[lane] = ((const float*)(ws + WS_BETA))[(growb + lane) * 8 + h];
    }
    __syncthreads();
    {
        const int which = w >> 2, mt = w & 3;
        const LAS bf16_t* Ab = (which ? QN : KN) + (16 * mt + r) * 136 + 8 * q;
        f32x4 acc[4];
#pragma unroll
        for (int nt = 0; nt < 4; ++nt) acc[nt] = (f32x4){0.f, 0.f, 0.f, 0.f};
#pragma unroll
        for (int ks = 0; ks < 4; ++ks) { const bf16x8 a = *(const LAS bf16x8*)(Ab + 32 * ks);
#pragma unroll
            for (int nt = 0; nt < 4; ++nt) { const bf16x8 b = *(const LAS bf16x8*)(KN + (16 * nt + r) * 136 + 32 * ks + 8 * q); acc[nt] = MFMA16(a, b, acc[nt]); } }
#pragma unroll
        for (int nt = 0; nt < 4; ++nt) { const int mcol = 16 * nt + r; const float gm = GCS[mcol];
#pragma unroll
            for (int i = 0; i < 4; ++i) { const int c = 16 * mt + 4 * q + i; const float dec = __expf(GCS[c] - gm);
                if (which == 0) LM[c * 65 + mcol] = (c > mcol) ? BTS[c] * acc[nt][i] * dec : 0.f;
                else TA[4096 + c * 64 + mcol] = (bf16_t)f2bf((c >= mcol) ? acc[nt][i] * dec : 0.f); } }
    }
    __syncthreads();
}
__device__ __forceinline__ void prepA_invert(const Params& p, LAS unsigned char* lds, int item, int slot) {
    int tid_ = threadIdx.x; asm volatile("" : "+v"(tid_)); const int lane = tid_ & 63;
    bf16_t* TA = (bf16_t*)(p.ws + WS_TA) + (size_t)item * 8192;
    const LAS float* LM = (const LAS float*)(lds + 34816 + slot * 17152);
    const LAS float* BTS = LM + 64 * 65 + 64;
    float t[64]; const float bt = BTS[lane];
#pragma unroll
    for (int i = 0; i < 64; ++i) {
        asm volatile("" ::: "memory");
        const float lrow = LM[i * 65 + lane];
        float a0 = (lane == i) ? 1.f : 0.f, a1 = 0.f;
#pragma unroll
        for (int j = 0; j < i; ++j) { const float l = __builtin_bit_cast(float, __builtin_amdgcn_readlane(__builtin_bit_cast(int, lrow), j));
            if (j & 1) a1 -= l * t[j]; else a0 -= l * t[j]; }
        t[i] = a0 + a1;
        TA[i * 64 + lane] = (bf16_t)f2bf(t[i] * bt);
    }
}

__device__ __forceinline__ void prepB_wave(const Params& p, int item, int mt) {
    int tid_ = threadIdx.x; asm volatile("" : "+v"(tid_)); const int lane = tid_ & 63, r = lane & 15, q = lane >> 4;
    const int bh = item >> 7, n = item & 127, bl = bh >> 2, h = bh & 3;
    const int rowh = bl * SEQ + n * 64;
    const bf16_t* out1 = (const bf16_t*)(p.ws + WS_OUT1);
    bf16_t* SC = (bf16_t*)(p.ws + WS_SC) + (size_t)item * 4096;
    const bf16_t* qb = out1 + (size_t)(rowh + 16 * mt + r) * LDO + 4096 + h * 256 + 8 * q;
    const bf16_t* kb = out1 + (size_t)(rowh + r) * LDO + 5120 + h * 256 + 8 * q;
    f32x4 acc[4];
#pragma unroll
    for (int nt = 0; nt < 4; ++nt) acc[nt] = (f32x4){0.f, 0.f, 0.f, 0.f};
#pragma unroll 2
    for (int ks = 0; ks < 8; ++ks) { const bf16x8 a = __builtin_nontemporal_load((const bf16x8*)(qb + 32 * ks));
#pragma unroll
        for (int nt = 0; nt < 4; ++nt) { const bf16x8 b = *(const bf16x8*)(kb + (size_t)(16 * nt) * LDO + 32 * ks); acc[nt] = MFMA16(a, b, acc[nt]); } }
    const float lg = log1pf(-exp2f(-5.f - (float)h));
#pragma unroll
    for (int nt = 0; nt < 4; ++nt) { const int mcol = 16 * nt + r;
#pragma unroll
        for (int i = 0; i < 4; ++i) { const int c = 16 * mt + 4 * q + i; const int d = c > mcol ? c - mcol : mcol - c;
            SC[c * 64 + mcol] = (bf16_t)f2bf(acc[nt][i] * __expf(lg * (float)d)); } }
}

__device__ __forceinline__ u32x2 pk4(f32x4 v) { u32x2 o; o.x = pk2(v[0], v[1]); o.y = pk2(v[2], v[3]); return o; }

__device__ __forceinline__ void scanA(const Params& p, LAS unsigned char* lds, int half, int pair, int slice) {
    int tid_ = threadIdx.x; asm volatile("" : "+v"(tid_)); const int tid = tid_, lane = tid & 63, w = tid >> 6, r = lane & 15, q = lane >> 4;
    const int bl = pair >> 3, h = pair & 7;
    unsigned char* ws = p.ws;
    bf16_t* out1 = (bf16_t*)(ws + WS_OUT1);
    const bf16_t* QKN = (const bf16_t*)(ws + WS_QKN); const bf16_t* TAb = (const bf16_t*)(ws + WS_TA) + (size_t)(pair * 128) * 8192; const float* GC = (const float*)(ws + WS_GC);
    float* SSQ = (float*)(ws + WS_SSQA);
    LAS bf16_t* KS = (LAS bf16_t*)lds;
    LAS bf16_t* QS = (LAS bf16_t*)(lds + 17408);
    LAS bf16_t* TS = (LAS bf16_t*)(lds + 34816);
    LAS bf16_t* AS = (LAS bf16_t*)(lds + 44032);
    LAS float* VT = (LAS float*)(lds + 53248);
    LAS bf16_t* ST = (LAS bf16_t*)(lds + 61952);
    LAS bf16_t* RT = (LAS bf16_t*)(lds + 70656);
    LAS bf16_t* VN = (LAS bf16_t*)(lds + 75264);
    LAS bf16_t* VD = (LAS bf16_t*)(lds + 79872);
    LAS float* EG = (LAS float*)(lds + 84480);
    LAS float* EK = (LAS float*)(lds + 84736);
    const int mt = w & 3, nt = w >> 2;
    const int vcp = tid & 15, vrg = tid >> 4;
    const int vch = 2048 + h * 256 + slice * 32 + 2 * vcp;
    const float cw0 = p.conv_a[vch], cw1 = p.conv_a[4096 + vch], cw2 = p.conv_a[8192 + vch], cw3 = p.conv_a[12288 + vch];
    const float dw0 = p.conv_a[vch + 1], dw1 = p.conv_a[4096 + vch + 1], dw2 = p.conv_a[8192 + vch + 1], dw3 = p.conv_a[12288 + vch + 1];
    f32x4 S[2] = {(f32x4){0.f, 0.f, 0.f, 0.f}, (f32x4){0.f, 0.f, 0.f, 0.f}};
    u32x4 pk[2][2], pq[2][2], pt[2], pa[2]; unsigned xv[2][5]; float pg[2] = {0.f, 0.f};
#define SA_LOAD(nn, s) do { const int rowc = bl * SEQ + (nn) * 64; \
        _Pragma("unroll") for (int i = 0; i < 2; ++i) { const int ch = tid + NTHREADS * i, rr = ch >> 4, cc = ch & 15; const bf16_t* s_ = QKN + (size_t)(rowc + rr) * 2048 + h * 128 + 8 * cc; pq[s][i] = *(const u32x4*)s_; pk[s][i] = *(const u32x4*)(s_ + 1024); } \
        { const bf16_t* t_ = TAb + (size_t)(nn) * 8192 + tid * 8; pt[s] = *(const u32x4*)t_; pa[s] = *(const u32x4*)(t_ + 4096); } \
        pg[s] = GC[((size_t)rowc + (tid & 63)) * 8 + h]; \
        { _Pragma("unroll") for (int j = 0; j < 5; ++j) { const int pos = (nn) * 64 + vrg * 2 - 3 + j; xv[s][j] = __builtin_nontemporal_load((const unsigned*)(out1 + (size_t)(bl * SEQ + (pos < 0 ? 0 : pos)) * LDO + vch)); } } } while (0)
#define SA_STORE(nn, s) do { \
        _Pragma("unroll") for (int i = 0; i < 2; ++i) { const int ch = tid + NTHREADS * i, rr = ch >> 4, cc = ch & 15; *(LAS u32x4*)(QS + rr * 136 + 8 * cc) = pq[s][i]; *(LAS u32x4*)(KS + rr * 136 + 8 * cc) = pk[s][i]; } \
        { const int rr = tid >> 3, cc = tid & 7; *(LAS u32x4*)(TS + rr * 72 + 8 * cc) = pt[s]; *(LAS u32x4*)(AS + rr * 72 + 8 * cc) = pa[s]; } \
        if (tid < 64) { const float gl = __shfl(pg[s], 63); EG[tid] = __expf(pg[s]); EK[tid] = __expf(gl - pg[s]); } \
        { float xf[5], xg[5]; _Pragma("unroll") for (int j = 0; j < 5; ++j) { const bool ok = ((nn) * 64 + vrg * 2 - 3 + j >= 0); xf[j] = ok ? bflo(xv[s][j]) : 0.f; xg[j] = ok ? bfhi(xv[s][j]) : 0.f; } \
            float y[2], z[2]; _Pragma("unroll") for (int i = 0; i < 2; ++i) { y[i] = siluf_(cw0 * xf[i] + cw1 * xf[i + 1] + cw2 * xf[i + 2] + cw3 * xf[i + 3]); z[i] = siluf_(dw0 * xg[i] + dw1 * xg[i + 1] + dw2 * xg[i + 2] + dw3 * xg[i + 3]); } \
            typedef float f32x2_ __attribute__((ext_vector_type(2))); \
            *(LAS f32x2_*)(VT + (2 * vcp) * 68 + vrg * 2) = (f32x2_){y[0], y[1]}; *(LAS f32x2_*)(VT + (2 * vcp + 1) * 68 + vrg * 2) = (f32x2_){z[0], z[1]}; } } while (0)
    SA_LOAD(0, 0);
    for (int i = tid; i < 32 * 136 / 2; i += NTHREADS) ((LAS unsigned*)ST)[i] = 0u;
    SA_STORE(0, 0);
    SA_LOAD(1, 1);
    LBAR();
#define SA_STEP(n, s) do { \
        { const int nn_ = (n) + 2 < 128 ? (n) + 2 : 127; SA_LOAD(nn_, s); } \
        const int c0 = 16 * mt + 4 * q; \
          \
        bf16x8 fa[4], fb[4], fq[4]; \
        _Pragma("unroll") for (int ks = 0; ks < 4; ++ks) { fa[ks] = *(const LAS bf16x8*)(KS + (16 * mt + r) * 136 + 32 * ks + 8 * q); fb[ks] = *(const LAS bf16x8*)(ST + (16 * nt + r) * 136 + 32 * ks + 8 * q); } \
        const f32x4 eg = *(const LAS f32x4*)(EG + c0); \
        const f32x4 vv = *(const LAS f32x4*)(VT + (16 * nt + r) * 68 + c0); \
        _Pragma("unroll") for (int ks = 0; ks < 4; ++ks) fq[ks] = *(const LAS bf16x8*)(QS + (16 * mt + r) * 136 + 32 * ks + 8 * q); \
        __builtin_amdgcn_sched_barrier(0); \
        { f32x4 acc = (f32x4){0.f, 0.f, 0.f, 0.f}; \
          __builtin_amdgcn_s_setprio(1); _Pragma("unroll") for (int ks = 0; ks < 4; ++ks) acc = MFMA16(fa[ks], fb[ks], acc); __builtin_amdgcn_s_setprio(0); \
          *(LAS u32x2*)(RT + (16 * nt + r) * 72 + c0) = pk4(vv - eg * acc); } \
        f32x4 aq = (f32x4){0.f, 0.f, 0.f, 0.f}; \
        _Pragma("unroll") for (int ks = 0; ks < 4; ++ks) aq = MFMA16(fq[ks], fb[ks], aq);     \
        LBAR(); \
          \
        { bf16x8 ta[2], tb[2]; \
          _Pragma("unroll") for (int ks = 0; ks < 2; ++ks) { ta[ks] = *(const LAS bf16x8*)(TS + (16 * mt + r) * 72 + 32 * ks + 8 * q); tb[ks] = *(const LAS bf16x8*)(RT + (16 * nt + r) * 72 + 32 * ks + 8 * q); } \
          const f32x4 ek = *(const LAS f32x4*)(EK + c0); \
          __builtin_amdgcn_sched_barrier(0); \
          f32x4 acc = (f32x4){0.f, 0.f, 0.f, 0.f}; \
          __builtin_amdgcn_s_setprio(1); _Pragma("unroll") for (int ks = 0; ks < 2; ++ks) acc = MFMA16(ta[ks], tb[ks], acc); __builtin_amdgcn_s_setprio(0); \
          *(LAS u32x2*)(VN + (16 * nt + r) * 72 + c0) = pk4(acc); \
          *(LAS u32x2*)(VD + (16 * nt + r) * 72 + c0) = pk4(acc * ek); } \
        LBAR(); \
          \
        { bf16x8 ua[2], ub[2], ga[2], gb[2][2]; \
          _Pragma("unroll") for (int ks = 0; ks < 2; ++ks) { ua[ks] = *(const LAS bf16x8*)(AS + (16 * mt + r) * 72 + 32 * ks + 8 * q); ub[ks] = *(const LAS bf16x8*)(VN + (16 * nt + r) * 72 + 32 * ks + 8 * q); } \
          _Pragma("unroll") for (int ks = 0; ks < 2; ++ks) { \
            _Pragma("unroll") for (int t_ = 0; t_ < 2; ++t_) { const v4i16_t tv = lds_tr16(KS + (32 * ks + 8 * q + 4 * t_ + (r >> 2)) * 136 + 16 * w + 4 * (r & 3)); ga[ks][4 * t_] = tv[0]; ga[ks][4 * t_ + 1] = tv[1]; ga[ks][4 * t_ + 2] = tv[2]; ga[ks][4 * t_ + 3] = tv[3]; }     \
            _Pragma("unroll") for (int n2 = 0; n2 < 2; ++n2) gb[ks][n2] = *(const LAS bf16x8*)(VD + (16 * n2 + r) * 72 + 32 * ks + 8 * q); } \
          const float ld = EG[63]; \
          __builtin_amdgcn_sched_barrier(0); \
          f32x4 aa = (f32x4){0.f, 0.f, 0.f, 0.f}; \
          _Pragma("unroll") for (int ks = 0; ks < 2; ++ks) aa = MFMA16(ua[ks], ub[ks], aa); \
          S[0] = S[0] * ld; S[1] = S[1] * ld; \
          __builtin_amdgcn_s_setprio(1); _Pragma("unroll") for (int ks = 0; ks < 2; ++ks) { \
            _Pragma("unroll") for (int n2 = 0; n2 < 2; ++n2) S[n2] = MFMA16(ga[ks], gb[ks][n2], S[n2]); } __builtin_amdgcn_s_setprio(0); \
          const f32x4 o = eg * aq + aa; \
          const int rowc = bl * SEQ + (n) * 64 + c0; \
          bf16_t* od = out1 + (size_t)rowc * LDO + h * 256 + slice * 32 + 16 * nt + r; \
          f32x4 sq = o * o; \
          _Pragma("unroll") for (int i = 0; i < 4; ++i) od[(size_t)i * LDO] = (bf16_t)f2bf(o[i]); \
          _Pragma("unroll") for (int i = 0; i < 4; ++i) sq[i] = row16_sum(sq[i]); \
          if (r == 0) { \
            _Pragma("unroll") for (int i = 0; i < 4; ++i) SSQ[((size_t)(rowc + i) * 8 + h) * 16 + slice * 2 + nt] = sq[i]; } \
        } \
        LBAR(); \
          \
        _Pragma("unroll") for (int n2 = 0; n2 < 2; ++n2) *(LAS u32x2*)(ST + (16 * n2 + r) * 136 + 16 * w + 4 * q) = pk4(S[n2]); \
        if ((n) + 1 < 128) SA_STORE((n) + 1, 1 - (s)); \
        LBAR(); \
    } while (0)
    for (int n = 0; n < 128; n += 2) { SA_STEP(n, 0); SA_STEP(n + 1, 1); }
#undef SA_STEP
#undef SA_LOAD
#undef SA_STORE
}

__device__ __forceinline__ void scanB(const Params& p, LAS unsigned char* lds, int pair, int slice) {
    int tid_ = threadIdx.x; asm volatile("" : "+v"(tid_)); const int tid = tid_, lane = tid & 63, w = tid >> 6, r = lane & 15, q = lane >> 4;
    const int bl = pair >> 2, h = pair & 3;
    unsigned char* ws = p.ws;
    bf16_t* out1 = (bf16_t*)(ws + WS_OUT1);
    const bf16_t* SCb = (const bf16_t*)(ws + WS_SC) + (size_t)(pair * 128) * 4096;
    float* SSQ = (float*)(ws + WS_SSQB);
    LAS bf16_t* QS = (LAS bf16_t*)lds;
    LAS bf16_t* KS = (LAS bf16_t*)(lds + 33792);
    LAS bf16_t* SS = (LAS bf16_t*)(lds + 67584);
    LAS bf16_t* VT = (LAS bf16_t*)(lds + 76800);
    LAS bf16_t* VD = (LAS bf16_t*)(lds + 81408);
    LAS bf16_t* ST = (LAS bf16_t*)(lds + 86016);
    const float lg = log1pf(-exp2f(-5.f - (float)h));
    const float cd = __expf(lg * 64.f);
    const int mt = w & 3, nt = w >> 2, c0 = 16 * mt + 4 * q;
    f32x4 qd;
#pragma unroll
    for (int i = 0; i < 4; ++i) qd[i] = __expf(lg * (float)(c0 + i + 1));
    const int vrow = tid >> 3, vpart = tid & 7;
    const float kdv = __expf(lg * (float)(63 - vrow));
    const int vcolg = 6144 + h * 512 + slice * 32;
    f32x4 S[2][2];
#pragma unroll
    for (int a = 0; a < 2; ++a)
#pragma unroll
        for (int b = 0; b < 2; ++b) S[a][b] = (f32x4){0.f, 0.f, 0.f, 0.f};
    u32x4 pq[1][4], pk[1][4], ps[1]; u32x2 pv[1];
#define SB_LOAD(nn, s) do { const int rowc = bl * SEQ + (nn) * 64; \
        _Pragma("unroll") for (int i = 0; i < 4; ++i) { const int ch = tid + NTHREADS * i, rr = ch >> 5, cc = ch & 31; const bf16_t* s_ = out1 + (size_t)(rowc + rr) * LDO + 4096 + h * 256 + 8 * cc; pq[s][i] = *(const u32x4*)s_; pk[s][i] = *(const u32x4*)(s_ + 1024); } \
        ps[s] = *(const u32x4*)(SCb + (size_t)(nn) * 4096 + tid * 8); \
        pv[s] = __builtin_nontemporal_load((const u32x2*)(out1 + (size_t)(rowc + vrow) * LDO + vcolg + 4 * vpart)); } while (0)
#define SB_STORE(s) do { \
        _Pragma("unroll") for (int i = 0; i < 4; ++i) { const int ch = tid + NTHREADS * i, rr = ch >> 5, cc = ch & 31; *(LAS u32x4*)(QS + rr * 264 + 8 * cc) = pq[s][i]; *(LAS u32x4*)(KS + rr * 264 + 8 * cc) = pk[s][i]; } \
        { const int rr = tid >> 3, cc = tid & 7; *(LAS u32x4*)(SS + rr * 72 + 8 * cc) = ps[s]; } \
        { const unsigned wv[2] = {pv[s].x, pv[s].y}; _Pragma("unroll") for (int j = 0; j < 2; ++j) { const unsigned d_ = pk2(bflo(wv[j]) * kdv, bfhi(wv[j]) * kdv); \
            VT[(4 * vpart + 2 * j) * 72 + vrow] = (bf16_t)(wv[j] & 0xffffu); VT[(4 * vpart + 2 * j + 1) * 72 + vrow] = (bf16_t)(wv[j] >> 16); \
            VD[(4 * vpart + 2 * j) * 72 + vrow] = (bf16_t)(d_ & 0xffffu); VD[(4 * vpart + 2 * j + 1) * 72 + vrow] = (bf16_t)(d_ >> 16); } } } while (0)
    SB_LOAD(0, 0);
    for (int i = tid; i < 32 * 264 / 2; i += NTHREADS) ((LAS unsigned*)ST)[i] = 0u;
    SB_STORE(0);
    LBAR();
#define SB_STEP(n, s) do { \
        { const int nn_ = (n) + 1 < 128 ? (n) + 1 : 127; SB_LOAD(nn_, 0); } \
        { bf16x8 fa[8], fb[8], sa[2], sb[2], ga[2][2], gb[2][2]; \
          _Pragma("unroll") for (int ks = 0; ks < 8; ++ks) { fa[ks] = *(const LAS bf16x8*)(QS + (16 * mt + r) * 264 + 32 * ks + 8 * q); fb[ks] = *(const LAS bf16x8*)(ST + (16 * nt + r) * 264 + 32 * ks + 8 * q); } \
          _Pragma("unroll") for (int ks = 0; ks < 2; ++ks) { sa[ks] = *(const LAS bf16x8*)(SS + (16 * mt + r) * 72 + 32 * ks + 8 * q); sb[ks] = *(const LAS bf16x8*)(VT + (16 * nt + r) * 72 + 32 * ks + 8 * q); } \
          __builtin_amdgcn_sched_barrier(0); \
          f32x4 a1 = (f32x4){0.f, 0.f, 0.f, 0.f}, a2 = (f32x4){0.f, 0.f, 0.f, 0.f}; \
          _Pragma("unroll") for (int ks = 0; ks < 8; ++ks) a1 = MFMA16(fa[ks], fb[ks], a1); \
          _Pragma("unroll") for (int ks = 0; ks < 2; ++ks) a2 = MFMA16(sa[ks], sb[ks], a2); \
          __builtin_amdgcn_sched_barrier(0); \
          _Pragma("unroll") for (int ks = 0; ks < 2; ++ks) { \
            _Pragma("unroll") for (int n2 = 0; n2 < 2; ++n2) gb[ks][n2] = *(const LAS bf16x8*)(VD + (16 * n2 + r) * 72 + 32 * ks + 8 * q); \
            _Pragma("unroll") for (int m2 = 0; m2 < 2; ++m2) { \
              _Pragma("unroll") for (int t_ = 0; t_ < 2; ++t_) { const v4i16_t tv = lds_tr16(KS + (32 * ks + 8 * q + 4 * t_ + (r >> 2)) * 264 + 32 * w + 16 * m2 + 4 * (r & 3)); ga[m2][ks][4 * t_] = tv[0]; ga[m2][ks][4 * t_ + 1] = tv[1]; ga[m2][ks][4 * t_ + 2] = tv[2]; ga[m2][ks][4 * t_ + 3] = tv[3]; } } } \
          __builtin_amdgcn_sched_barrier(0); \
          _Pragma("unroll") for (int m2 = 0; m2 < 2; ++m2) { S[m2][0] = S[m2][0] * cd; S[m2][1] = S[m2][1] * cd; \
            _Pragma("unroll") for (int ks = 0; ks < 2; ++ks) { \
              _Pragma("unroll") for (int n2 = 0; n2 < 2; ++n2) S[m2][n2] = MFMA16(ga[m2][ks], gb[ks][n2], S[m2][n2]); } } \
          const f32x4 o = qd * a1 + a2; \
          const int rowc = bl * SEQ + (n) * 64 + c0; \
          bf16_t* od = out1 + (size_t)rowc * LDO + vcolg + 16 * nt + r; \
          f32x4 sq = o * o; \
          _Pragma("unroll") for (int i = 0; i < 4; ++i) od[(size_t)i * LDO] = (bf16_t)f2bf(o[i]); \
          _Pragma("unroll") for (int i = 0; i < 4; ++i) sq[i] = row16_sum(sq[i]); \
          if (r == 0) { \
            _Pragma("unroll") for (int i = 0; i < 4; ++i) SSQ[((size_t)(rowc + i) * 4 + h) * 32 + slice * 2 + nt] = sq[i]; } \
        } \
        LBAR(); \
        _Pragma("unroll") for (int m2 = 0; m2 < 2; ++m2) { \
          _Pragma("unroll") for (int n2 = 0; n2 < 2; ++n2) *(LAS u32x2*)(ST + (16 * n2 + r) * 264 + 32 * w + 16 * m2 + 4 * q) = pk4(S[m2][n2]); } \
        if ((n) + 1 < 128) SB_STORE(0); \
        LBAR(); \
    } while (0)
    for (int n = 0; n < 128; n += 2) { SB_STEP(n, 0); SB_STEP(n + 1, 1); }
#undef SB_STEP
#undef SB_LOAD
#undef SB_STORE
}

#define XB_TMO      128
#define XB_XCNT(j)  (256  + 64 * (j))
#define XB_XSUB(j)  (1280 + 64 * (j))
#define XB_XGEN(j)  (2304 + 64 * (j))
#define XB_TOP      3328
#define XB_TOPGEN   3392
#define XCD_BAR_WORDS 3456
#define XB_SPIN_CAP (1u << 18)

__device__ __forceinline__ unsigned xb_ld(unsigned* p)              { return __hip_atomic_load(p, __ATOMIC_RELAXED, __HIP_MEMORY_SCOPE_AGENT); }
__device__ __forceinline__ unsigned xb_add(unsigned* p, unsigned v) { return __hip_atomic_fetch_add(p, v, __ATOMIC_RELAXED, __HIP_MEMORY_SCOPE_AGENT); }
__device__ __forceinline__ unsigned xb_xcc_id() { return (unsigned)__builtin_amdgcn_s_getreg((3 << 11) | 20) & 0xFu; }
#define XB_SPIN(cond, bar) do { unsigned _sp = 0; while (cond) { __builtin_amdgcn_s_sleep(1); \
    if ((++_sp & 255u) == 0u) { if (xb_ld(&(bar)[XB_TMO])) break; if (_sp > XB_SPIN_CAP) { atomicAdd(&(bar)[XB_TMO], 1u); break; } } } } while (0)

struct XcdBarrier {
    unsigned* bar; unsigned x;
    volatile LAS unsigned* st;
};

__device__ __forceinline__ XcdBarrier xcd_barrier_post(unsigned* bar, volatile LAS unsigned* st) {
    XcdBarrier b; b.bar = bar; b.x = xb_xcc_id(); b.st = st;
    if (threadIdx.x == 0) (void)xb_add(&bar[XB_XCNT(b.x)], 1u);
    return b;
}
__device__ __forceinline__ void xcd_barrier_complete(unsigned* bar, unsigned x, unsigned& nloc, unsigned& nx) {
    const unsigned G = gridDim.x * gridDim.y * gridDim.z;
    unsigned sum, cnt, mine, sp = 0u;
    for (;;) {
        sum = 0u; cnt = 0u; mine = 0u;
#pragma unroll
        for (unsigned j = 0; j < 16; ++j) { const unsigned c = xb_ld(&bar[XB_XCNT(j)]); sum += c; cnt += (c > 0u) ? 1u : 0u; mine = (j == x) ? c : mine; }
        if (sum == G) break;
        __builtin_amdgcn_s_sleep(1);
        if ((++sp & 255u) == 0u) { if (xb_ld(&bar[XB_TMO])) break; if (sp > XB_SPIN_CAP) { atomicAdd(&bar[XB_TMO], 1u); break; } }
    }
    nloc = mine > 0u ? mine : 1u; nx = cnt > 0u ? cnt : 1u;
}

__device__ __forceinline__ void xcd_barrier(const XcdBarrier& b) {
    asm volatile("s_waitcnt vmcnt(0)" ::: "memory");
    __syncthreads();
    int xt_ = threadIdx.x; asm volatile("" : "+v"(xt_));
    if (xt_ == 0) {
        unsigned* bar = b.bar;
        __builtin_amdgcn_s_waitcnt(0);
        unsigned nloc = b.st[0], nx = b.st[1];
        if (nloc == 0u) { xcd_barrier_complete(bar, b.x, nloc, nx); b.st[0] = nloc; b.st[1] = nx; }
        const unsigned old = xb_add(&bar[XB_XSUB(b.x)], 1u);
        const unsigned gen = old / nloc;
        if (old + 1u == (gen + 1u) * nloc) {
            __builtin_amdgcn_fence(__ATOMIC_RELEASE, "agent");
            asm volatile("s_waitcnt vmcnt(0)" ::: "memory");
            const unsigned og = xb_add(&bar[XB_TOP], 1u);
            const unsigned tg = og / nx;
            if (og + 1u == (tg + 1u) * nx) xb_add(&bar[XB_TOPGEN], 1u);
            else XB_SPIN(xb_ld(&bar[XB_TOPGEN]) == tg, bar);
            __builtin_amdgcn_fence(__ATOMIC_ACQUIRE, "agent");
            xb_add(&bar[XB_XGEN(b.x)], 1u);
            asm volatile("s_waitcnt vmcnt(0)" ::: "memory");
        } else {
            XB_SPIN(xb_ld(&bar[XB_XGEN(b.x)]) == gen, bar);
            __builtin_amdgcn_fence(__ATOMIC_ACQUIRE, "agent");
            asm volatile("s_waitcnt vmcnt(0)" ::: "memory");
        }
    }
    __syncthreads();
}


typedef const __attribute__((address_space(4))) Params* kparams_t;
__device__ __forceinline__ Params load_params() {
#if defined(__HIP_DEVICE_COMPILE__)
    kparams_t kp = (kparams_t)__builtin_amdgcn_kernarg_segment_ptr(); asm volatile("" : "+s"(kp)); return *kp;
#else
    return Params{};
#endif
}
__global__ void __launch_bounds__(NTHREADS) hybrid_fwd(Params p_unused) {
    extern __shared__ __attribute__((aligned(16))) unsigned char lds_raw[];
    LAS unsigned char* lds = (LAS unsigned char*)lds_raw;
    cg::grid_group grid = cg::this_grid();
    using pg8::Gemm; using pg8::StaticOrder;
#define PH_BEGIN { const Params p = load_params(); unsigned char* ws = p.ws; int G_ = gridDim.x, bx_ = blockIdx.x; asm volatile("" : "+s"(G_), "+s"(bx_)); const int G = G_, bx = bx_; (void)ws; (void)G; (void)bx;
#define GRID_BAR() do { XcdBarrier xb_; xb_.bar = (unsigned*)load_params().ws; unsigned x_ = xcc_; asm volatile("" : "+s"(x_)); xb_.x = x_; xb_.st = xst; xcd_barrier(xb_); } while (0)
#define PH_END } GRID_BAR();
    volatile LAS unsigned* xst = (volatile LAS unsigned*)(lds + LDS_BYTES - 64);
    if (threadIdx.x < 16) xst[threadIdx.x] = 0u;
    __syncthreads();
    unsigned xcc_;
    { const Params p0 = load_params(); const XcdBarrier xbar = xcd_barrier_post((unsigned*)p0.ws, xst); xcc_ = __builtin_amdgcn_readfirstlane(xbar.x); }

    { const Params p = load_params(); prologue(p, lds); }
    { const Params p = load_params(); if (p.ws == nullptr) grid.sync(); }
    GRID_BAR();

    for (int half = 0; half < 2; ++half) {
        PH_BEGIN
          Gemm g{(const bf16_t*)(ws + WS_XN) + (size_t)half * MH * D, D, (const bf16_t*)(ws + WS_W1A), MH, 8192, D}; StaticOrder S; S.init(MH, 8192, G, bx);
          pg8::Epi<1> E{}; E.out1 = (bf16_t*)(ws + WS_OUT1); E.ropec = (const float*)(ws + WS_ROPEC); E.ropes = (const float*)(ws + WS_ROPES);
          pg8::gemm_phase<pg8::Epi<1>, StaticOrder, true>(lds, g, S, E);
        PH_END
        PH_BEGIN
          for (int it = bx; it < 2048; it += 4 * G) {
#pragma unroll 1
            for (int sl = 0; sl < 4; ++sl) prepA_item(p, lds, half, it + sl * G, sl);
            int tid2_ = threadIdx.x; asm volatile("" : "+v"(tid2_)); const int wv_ = tid2_ >> 6;
            if (wv_ < 4) prepA_invert(p, lds, it + wv_ * G, wv_);
            else { const int b0 = bx + ((it - bx) >> 1); prepB_wave(p, b0, wv_ - 4); prepB_wave(p, b0 + G, wv_ - 4); }
            __syncthreads(); }
        PH_END
        PH_BEGIN
          for (int it = bx; it < 256; it += G) { const int xcd = it & 7, slot = it >> 3;
            if (slot < 16) scanA(p, lds, half, xcd * 2 + (slot >> 3), slot & 7); else scanB(p, lds, xcd, slot - 16);
            __syncthreads(); }
        PH_END
        PH_BEGIN
          Gemm g{(const bf16_t*)(ws + WS_XN) + (size_t)half * MH * D, D, (const bf16_t*)(ws + WS_W1B), MH, 6144, D}; StaticOrder S; S.init(MH, 6144, G, bx);
          pg8::Epi<4> E{}; E.lds_top = lds + pg8::STAGE_BYTES; E.out1 = (bf16_t*)(ws + WS_OUT1); E.gso = (bf16_t*)(ws + WS_QKN); E.ssqa = (const float*)(ws + WS_SSQA); E.ssqb = (const float*)(ws + WS_SSQB); E.norm_a = p.norm_a; E.norm_b = p.norm_b;
          pg8::gemm_phase<pg8::Epi<4>, StaticOrder, true>(lds, g, S, E);
        PH_END
        PH_BEGIN
          Gemm g{(const bf16_t*)(ws + WS_OUT1), LDO, (const bf16_t*)(ws + WS_WBRA), MH, D, 4096, (6144 - 2048) * 2}; StaticOrder S; S.init(MH, D, G, bx);
          pg8::Epi<13> E{}; E.gs = (const bf16_t*)(ws + WS_QKN); E.ob = (bf16_t*)(ws + WS_TA);
          pg8::gemm_phase<pg8::Epi<13>, StaticOrder, true>(lds, g, S, E);
        PH_END
        PH_BEGIN
          Gemm g{(const bf16_t*)(ws + WS_TA), D, (const bf16_t*)(ws + WS_WOUT), MH, D, D}; StaticOrder S; S.init(MH, D, G, bx);
          pg8::Epi<12> E{}; E.of = p.out + (size_t)half * MH * D; E.xin = p.x + (size_t)half * MH * D; E.hn = (bf16_t*)(ws + WS_QKN);     E.nw = p.n_mix_post; E.nw2 = p.n_mlp_pre;
          E.xbuf = (unsigned*)(ws + WS_SSQA + (size_t)(half * 3 + 1) * 262144); E.cnt = (unsigned*)(ws + 16384) + (half * 3 + 1) * 4096;
          E.xbuf2 = (unsigned*)(ws + WS_SSQA + (size_t)(half * 3 + 2) * 262144); E.cnt2 = (unsigned*)(ws + 16384) + (half * 3 + 2) * 4096;
          pg8::gemm_phase<pg8::Epi<12>, StaticOrder, false>(lds, g, S, E);
        PH_END
        PH_BEGIN
          Gemm g{(const bf16_t*)(ws + WS_QKN), D, (const bf16_t*)(ws + WS_WUP), MH, FF, D}; StaticOrder S; S.init(MH, FF, G, bx);
          pg8::Epi<9> E{}; E.ob = (bf16_t*)(ws + WS_OUT1);
          pg8::gemm_phase<pg8::Epi<9>, StaticOrder, true>(lds, g, S, E);
        PH_END
        PH_BEGIN
          Gemm g{(const bf16_t*)(ws + WS_OUT1), FF, (const bf16_t*)(ws + WS_WDN), MH, D, FF}; StaticOrder S; S.init(MH, D, G, bx);
          pg8::Epi<11> E{}; E.of = p.out + (size_t)half * MH * D; E.nw = p.n_mlp_post;
          E.xbuf = (unsigned*)(ws + WS_SSQA + (size_t)(half * 3) * 262144); E.cnt = (unsigned*)(ws + 16384) + (half * 3) * 4096;
          pg8::gemm_phase<pg8::Epi<11>, StaticOrder, false>(lds, g, S, E);
        } if (half == 0) GRID_BAR();
    }
#undef PH_BEGIN
#undef PH_END
}

extern "C" void kernel_launch(void* const* d_in, const int* in_sizes, int n_in, void* d_out, int out_size, void* d_ws, size_t ws_size, hipStream_t stream) {
    static int grid = 0;
    if (grid == 0) {
        if (n_in != 16 || in_sizes[0] != M * D || out_size != M * D || ws_size < WS_END) { fprintf(stderr, "kernel_launch: unexpected shapes / workspace (n_in %d, ws %zu)\n", n_in, ws_size); grid = -1; return; }
        int dev = 0, cus = 0, per_cu = 0;
        hipGetDevice(&dev); hipDeviceGetAttribute(&cus, hipDeviceAttributeMultiprocessorCount, dev);
        if (hipFuncSetAttribute((const void*)hybrid_fwd, hipFuncAttributeMaxDynamicSharedMemorySize, LDS_BYTES) != hipSuccess) { fprintf(stderr, "kernel_launch: hipFuncSetAttribute failed\n"); grid = -1; return; }
        if (hipOccupancyMaxActiveBlocksPerMultiprocessor(&per_cu, (const void*)hybrid_fwd, NTHREADS, LDS_BYTES) != hipSuccess || per_cu < 1) { fprintf(stderr, "kernel_launch: occupancy query failed (%d)\n", per_cu); grid = -1; (void)hipGetLastError(); return; }
        grid = 1; while (grid * 2 <= cus && grid < 512) grid *= 2;
    }
    if (grid < 0) return;
    if (hipMemsetAsync(d_ws, 0, 131072, stream) != hipSuccess) { fprintf(stderr, "kernel_launch: hipMemsetAsync of the barrier words failed\n"); return; }
    Params p{};
    p.x = (const float*)d_in[0]; p.n_mix_pre = (const float*)d_in[1]; p.n_mix_post = (const float*)d_in[2]; p.n_mlp_pre = (const float*)d_in[3]; p.n_mlp_post = (const float*)d_in[4];
    p.w_in = (const float*)d_in[5]; p.conv_a = (const float*)d_in[6]; p.a_log = (const float*)d_in[7]; p.dt_bias = (const float*)d_in[8]; p.norm_a = (const float*)d_in[9]; p.norm_b = (const float*)d_in[10];
    p.w_br_a = (const float*)d_in[11]; p.w_br_b = (const float*)d_in[12]; p.w_out = (const float*)d_in[13]; p.w_up = (const float*)d_in[14]; p.w_down = (const float*)d_in[15];
    p.out = (float*)d_out; p.ws = (unsigned char*)d_ws;
    void* args[] = {&p};
    hipError_t e = hipLaunchCooperativeKernel((const void*)hybrid_fwd, dim3(grid), dim3(NTHREADS), args, LDS_BYTES, stream);
    if (e != hipSuccess) fprintf(stderr, "kernel_launch: cooperative launch failed: %s (grid %d)\n", hipGetErrorString(e), grid);
}

static_assert(WS_OUT1 + (size_t)MH * LDO * 2 <= WS_QKN && WS_END <= 512 * MiB, "d_ws map");
```
